# Optimizing an MI355X kernel written in HIP

```python
import math
import jax, jax.numpy as jnp
from jax import lax
import numpy as np


D_MODEL = 1024
BATCH = 4
SEQ = 4096
DEPTH = 1

HEAD_DIM = 64
ATTN_WIDTH = D_MODEL // 2
N_ATTN_HEADS = ATTN_WIDTH // HEAD_DIM
REC_WIDTH = D_MODEL - ATTN_WIDTH
REC_BLOCKS = 8
REC_BLOCK = REC_WIDTH // REC_BLOCKS
MIX_WIDTH = ATTN_WIDTH + REC_WIDTH
IN_WIDTH = 3 * ATTN_WIDTH + 2 * REC_WIDTH
REC_CONV = 4
LRU_C = 8.0
D_FF = 3 * D_MODEL
FFN_CONV = 3
WINDOW_DILATIONS = ((128, 1), (512, 4), (2048, 16))
BLOCK = 128
ROPE_THETA = 10000.0
EPS = 1e-6
NEG_INF = -1e30

kernel_name = "hybrid_dilated_attn_rglru_convffn"


def rms_norm(x, g):
    xf = x.astype(jnp.float32)
    y = xf * lax.rsqrt(jnp.mean(xf * xf, axis=-1, keepdims=True) + EPS)
    return (y * g.astype(jnp.float32)).astype(x.dtype)


def rotary(x, positions):
    half = HEAD_DIM // 2
    inv_freq = ROPE_THETA ** (-jnp.arange(half, dtype=jnp.float32) / half)
    ang = positions.astype(jnp.float32)[..., None] * inv_freq
    cos = jnp.cos(ang)[:, :, None, :]
    sin = jnp.sin(ang)[:, :, None, :]
    xf = x.astype(jnp.float32)
    x1, x2 = xf[..., :half], xf[..., half:]
    return jnp.concatenate([x1 * cos - x2 * sin, x2 * cos + x1 * sin], axis=-1).astype(x.dtype)


def causal_depthwise_conv(x, w, b):
    k_width = w.shape[0]
    s = x.shape[1]
    xp = jnp.pad(x, ((0, 0), (k_width - 1, 0), (0, 0)))
    y = b
    for k in range(k_width):
        y = y + xp[:, k:k + s, :] * w[k]
    return y


def dilated_window_branch(q, k, v, window, dilation):
    bsz, s, h, d = q.shape
    length = s // dilation
    span = window // dilation
    assert span <= BLOCK
    nb = -(-length // BLOCK)
    lp = nb * BLOCK

    def regroup(t):
        return t.reshape(bsz, length, dilation, h, d).transpose(0, 2, 3, 1, 4)

    qs = jnp.pad(regroup(q), ((0, 0), (0, 0), (0, 0), (0, lp - length), (0, 0)))
    ks = jnp.pad(regroup(k), ((0, 0), (0, 0), (0, 0), (BLOCK, lp - length), (0, 0)))
    vs = jnp.pad(regroup(v), ((0, 0), (0, 0), (0, 0), (BLOCK, lp - length), (0, 0)))
    qb = qs.reshape(bsz, dilation, h, nb, BLOCK, d)
    kb = ks.reshape(bsz, dilation, h, nb + 1, BLOCK, d)
    vb = vs.reshape(bsz, dilation, h, nb + 1, BLOCK, d)
    kwin = jnp.concatenate([kb[:, :, :, :-1], kb[:, :, :, 1:]], axis=4)
    vwin = jnp.concatenate([vb[:, :, :, :-1], vb[:, :, :, 1:]], axis=4)

    scores = jnp.einsum('bchnqd,bchnkd->bchnqk', qb, kwin).astype(jnp.float32)
    qi = jnp.arange(BLOCK)[:, None]
    kj = jnp.arange(2 * BLOCK)[None, :]
    rel = qi - kj + BLOCK
    band = (rel >= 0) & (rel <= span)
    blk = jnp.arange(nb)[:, None, None]
    key_ok = (blk * BLOCK + kj[None] - BLOCK) >= 0
    mask = band[None] & key_ok
    scores = jnp.where(mask, scores, NEG_INF)
    m = jnp.max(scores, axis=-1, keepdims=True)
    p = jnp.exp(scores - m)
    l = jnp.sum(p, axis=-1, keepdims=True)
    o = jnp.einsum('bchnqk,bchnkd->bchnqd', p, vwin.astype(jnp.float32)) / l
    lse = (m + jnp.log(l))[..., 0]

    o = o.reshape(bsz, dilation, h, lp, d)[:, :, :, :length]
    lse = lse.reshape(bsz, dilation, h, lp)[:, :, :, :length]
    o = o.transpose(0, 3, 1, 2, 4).reshape(bsz, s, h, d)
    lse = lse.transpose(0, 3, 1, 2).reshape(bsz, s, h)
    return o, lse


def dilated_attention(q, k, v):
    outs, lses = [], []
    for window, dilation in WINDOW_DILATIONS:
        o, lse = dilated_window_branch(q, k, v, window, dilation)
        outs.append(o)
        lses.append(lse)
    wts = jax.nn.softmax(jnp.stack(lses, axis=0), axis=0)
    return jnp.einsum('gbsh,gbshd->bshd', wts, jnp.stack(outs, axis=0))


def lru_combine(left, right):
    a_l, b_l = left
    a_r, b_r = right
    return a_l * a_r, a_r * b_l + b_r


def rg_lru(xr, w_rg, b_rg, w_ig, b_ig, lru_lambda):
    bsz, s, _ = xr.shape
    xb = xr.reshape(bsz, s, REC_BLOCKS, REC_BLOCK)
    r = jax.nn.sigmoid(jnp.einsum('bsnc,ncd->bsnd', xb, w_rg) + b_rg).reshape(bsz, s, REC_WIDTH)
    i = jax.nn.sigmoid(jnp.einsum('bsnc,ncd->bsnd', xb, w_ig) + b_ig).reshape(bsz, s, REC_WIDTH)
    r = r.astype(jnp.float32)
    i = i.astype(jnp.float32)
    log_a = -LRU_C * r * jax.nn.softplus(-lru_lambda.astype(jnp.float32))
    a = jnp.exp(log_a)
    mult = jnp.sqrt(-jnp.expm1(2.0 * log_a))
    u = mult * (i * xr.astype(jnp.float32))
    _, hseq = lax.associative_scan(lru_combine, (a, u), axis=1)
    return hseq.astype(xr.dtype)


def setup_inputs(seed: int = 0) -> dict:
    key = jax.random.key(seed)
    ks = jax.random.split(key, 24)
    f32 = jnp.float32

    def nrm(k, shape, scale):
        return jax.random.normal(k, shape, f32) * scale

    def gain(k, shape):
        return 1.0 + 0.01 * jax.random.normal(k, shape, f32)

    x = jax.random.normal(ks[0], (BATCH, SEQ, D_MODEL), f32)
    positions = jnp.broadcast_to(jnp.arange(SEQ, dtype=jnp.int32)[None, :], (BATCH, SEQ))
    a_c = jax.random.uniform(ks[11], (DEPTH, REC_WIDTH), f32, 0.9, 0.999)
    sig = a_c ** (1.0 / LRU_C)
    lru_lambda = jnp.log(sig) - jnp.log1p(-sig)
    return {
        "x": x,
        "positions": positions,
        "g_mix": gain(ks[1], (DEPTH, D_MODEL)),
        "w_in": nrm(ks[2], (DEPTH, D_MODEL, IN_WIDTH), D_MODEL ** -0.5),
        "q_norm_g": gain(ks[3], (DEPTH, HEAD_DIM)),
        "k_norm_g": gain(ks[4], (DEPTH, HEAD_DIM)),
        "rec_conv_w": nrm(ks[5], (DEPTH, REC_CONV, REC_WIDTH), REC_CONV ** -0.5),
        "rec_conv_b": nrm(ks[6], (DEPTH, REC_WIDTH), 0.01),
        "w_rg": nrm(ks[7], (DEPTH, REC_BLOCKS, REC_BLOCK, REC_BLOCK), REC_BLOCK ** -0.5),
        "b_rg": nrm(ks[8], (DEPTH, REC_BLOCKS, REC_BLOCK), 0.01),
        "w_ig": nrm(ks[9], (DEPTH, REC_BLOCKS, REC_BLOCK, REC_BLOCK), REC_BLOCK ** -0.5),
        "b_ig": nrm(ks[10], (DEPTH, REC_BLOCKS, REC_BLOCK), 0.01),
        "lru_lambda": lru_lambda,
        "g_attn_out": gain(ks[12], (DEPTH, ATTN_WIDTH)),
        "g_rec_out": gain(ks[13], (DEPTH, REC_WIDTH)),
        "w_out": nrm(ks[14], (DEPTH, MIX_WIDTH, D_MODEL), MIX_WIDTH ** -0.5),
        "g_ffn": gain(ks[15], (DEPTH, D_MODEL)),
        "w_up": nrm(ks[16], (DEPTH, D_MODEL, 2 * D_FF), D_MODEL ** -0.5),
        "ffn_conv_w": nrm(ks[17], (DEPTH, FFN_CONV, 2 * D_FF), FFN_CONV ** -0.5),
        "ffn_conv_b": nrm(ks[18], (DEPTH, 2 * D_FF), 0.01),
        "w_down": nrm(ks[19], (DEPTH, D_FF, D_MODEL), D_FF ** -0.5),
    }


def reference(x, positions, g_mix, w_in, q_norm_g, k_norm_g, rec_conv_w, rec_conv_b,
              w_rg, b_rg, w_ig, b_ig, lru_lambda, g_attn_out, g_rec_out, w_out,
              g_ffn, w_up, ffn_conv_w, ffn_conv_b, w_down):
    bsz, s, _ = x.shape
    for layer in range(DEPTH):
        h = rms_norm(x, g_mix[layer])
        proj = h @ w_in[layer]
        q, k, v, xr, gr = jnp.split(
            proj, [ATTN_WIDTH, 2 * ATTN_WIDTH, 3 * ATTN_WIDTH, 3 * ATTN_WIDTH + REC_WIDTH], axis=-1)
        q = q.reshape(bsz, s, N_ATTN_HEADS, HEAD_DIM)
        k = k.reshape(bsz, s, N_ATTN_HEADS, HEAD_DIM)
        v = v.reshape(bsz, s, N_ATTN_HEADS, HEAD_DIM)
        q = rotary(rms_norm(q, q_norm_g[layer]), positions) * (HEAD_DIM ** -0.5)
        k = rotary(rms_norm(k, k_norm_g[layer]), positions)
        attn = dilated_attention(q, k, v).astype(x.dtype).reshape(bsz, s, ATTN_WIDTH)
        attn = rms_norm(attn, g_attn_out[layer])

        xr = causal_depthwise_conv(xr, rec_conv_w[layer], rec_conv_b[layer])
        rec = rg_lru(xr, w_rg[layer], b_rg[layer], w_ig[layer], b_ig[layer], lru_lambda[layer])
        rec = rms_norm(rec * jax.nn.gelu(gr), g_rec_out[layer])

        x = x + jnp.concatenate([attn, rec], axis=-1) @ w_out[layer]

        h = rms_norm(x, g_ffn[layer])
        u = causal_depthwise_conv(h @ w_up[layer], ffn_conv_w[layer], ffn_conv_b[layer])
        gate, up = jnp.split(u, 2, axis=-1)
        x = x + (jax.nn.gelu(gate) * up) @ w_down[layer]
    return x
```

```cpp
#include <hip/hip_runtime.h>
#include <hip/hip_cooperative_groups.h>
#include <cstdio>
#include <cstdint>
namespace cg = cooperative_groups;
#ifndef REP_SYNC
#define REP_SYNC 0
#endif
#ifndef REP_P0
#define REP_P0 1
#endif
#ifndef REP_P1
#define REP_P1 1
#endif
#ifndef REP_LRUA
#define REP_LRUA 1
#endif
#ifndef REP_P2
#define REP_P2 1
#endif
#ifndef REP_P3
#define REP_P3 1
#endif
#ifndef REP_P5
#define REP_P5 1
#endif
#ifndef REPG_P1
#define REPG_P1 1
#endif
#ifndef REPG_P5
#define REPG_P5 1
#endif
#ifndef REPI_P2
#define REPI_P2 1
#endif

#define LAS __attribute__((address_space(3)))
typedef unsigned short bf16_t;
typedef short bf16x8 __attribute__((ext_vector_type(8)));
typedef float f32x4 __attribute__((ext_vector_type(4)));
typedef float f32x2 __attribute__((ext_vector_type(2)));
typedef unsigned u32x4 __attribute__((ext_vector_type(4)));
typedef unsigned u32x2 __attribute__((ext_vector_type(2)));

constexpr int MTOK = 16384, SEQ = 4096, DM = 1024, NIN = 2560, DFF = 3072, NUP = 6144;
constexpr float EPS = 1e-6f;
constexpr float LOG2E = 1.4426950408889634f;

constexpr size_t MiB = 1u << 20;
constexpr size_t WS_RS = 0;
constexpr size_t WS_BAR = 65536;
constexpr size_t WS_RS0 = 262144;
constexpr size_t WS_CHS = 1 * MiB;
constexpr size_t WS_CS = 2 * MiB;
constexpr size_t WS_LSUM = 6 * MiB;
constexpr size_t WS_WG = 7 * MiB + 512 * 1024;
constexpr size_t WS_ZERO_BYTES = 131072;
constexpr size_t WS_WIN = 8 * MiB;
constexpr size_t WS_WOUT = 13 * MiB;
constexpr size_t WS_WDN = 15 * MiB;
constexpr size_t WS_WUP = 21 * MiB;
constexpr size_t WS_HT = 33 * MiB;
constexpr size_t WS_HB = 36 * MiB;
constexpr size_t WS_XN = 40 * MiB;
constexpr size_t WS_PROJ = 72 * MiB;
constexpr size_t WS_OB = 152 * MiB;
constexpr size_t WS_MIX = 200 * MiB;
constexpr size_t WS_ACT = 72 * MiB;
constexpr size_t WS_END = 232 * MiB;

constexpr int LDS_BYTES = 155648;
constexpr int XLDS_OFF = 131072;
constexpr int MISC_OFF = 155648 - 64;

__device__ __forceinline__ unsigned f2bf(float f) { unsigned u = __builtin_bit_cast(unsigned, f); return (u + 0x7fffu + ((u >> 16) & 1u)) >> 16; }
__device__ __forceinline__ unsigned pk2(float lo, float hi) { unsigned r; asm("v_cvt_pk_bf16_f32 %0, %1, %2" : "=v"(r) : "v"(lo), "v"(hi)); return r; }
__device__ __forceinline__ float bf_lo(unsigned w) { return __builtin_bit_cast(float, w << 16); }
__device__ __forceinline__ float bf_hi(unsigned w) { return __builtin_bit_cast(float, w & 0xffff0000u); }
__device__ __forceinline__ float bf2f(bf16_t h) { return __builtin_bit_cast(float, (unsigned)h << 16); }
__device__ __forceinline__ float fast_exp2(float x) { return __builtin_amdgcn_exp2f(x); }
__device__ __forceinline__ float fast_rcp(float x) { return __builtin_amdgcn_rcpf(x); }
__device__ __forceinline__ float sigmoidf_(float z) { return fast_rcp(1.f + fast_exp2(-z * LOG2E)); }
__device__ __forceinline__ float gelu_tanh(float x) { const float t = x * fmaf(x * x, -2.f * LOG2E * 0.7978845608028654f * 0.044715f, -2.f * LOG2E * 0.7978845608028654f); return x * fast_rcp(1.f + fast_exp2(t)); }
__device__ __forceinline__ float wave_sum(float v) {
#pragma unroll
    for (int o = 1; o < 64; o <<= 1) v += __shfl_xor(v, o);
    return v;
}
__device__ __forceinline__ float wave_max(float v) {
#pragma unroll
    for (int o = 1; o < 64; o <<= 1) v = fmaxf(v, __shfl_xor(v, o));
    return v;
}
__device__ __forceinline__ int fresh_lane() { int l; asm volatile("v_mbcnt_lo_u32_b32 %0, -1, 0\n\tv_mbcnt_hi_u32_b32 %0, -1, %0" : "=v"(l)); return l; }
template <int CTRL> __device__ __forceinline__ float dpp_f(float old, float src) {
    return __builtin_bit_cast(float, __builtin_amdgcn_update_dpp(__builtin_bit_cast(int, old), __builtin_bit_cast(int, src), CTRL, 0xF, 0xF, false));
}

namespace pg8 {
constexpr int BM = 256, BK = 64, HALF = 128, HTB = HALF * BK * 2, STAGE_BYTES = 8 * HTB, NXCD = 8, WGM = 8;
__host__ __device__ __forceinline__ int lds_byte(int r, int c) { const int st = (r >> 4) * 2 + (c >> 5), rr = r & 15, cc = c & 31, ob = rr * 64 + cc * 2; return st * 1024 + (ob ^ (((ob >> 9) & 1) << 5)); }
__host__ __device__ __forceinline__ void stage_rc(int b, int& R, int& C) { const int st = b / 1024, sb = b % 1024, swz = sb ^ (((sb >> 9) & 1) << 5); R = (st >> 1) * 16 + swz / 64; C = (st & 1) * 32 + (swz % 64) / 2; }
__host__ __device__ __forceinline__ int perm32(int rho) { const int n = rho >> 4, i = rho & 15; return 8 * (i >> 2) + 4 * n + (i & 3); }

struct Unit { int pm, pn; };
struct Gemm { const bf16_t* A; const bf16_t* Bt; int M, N, K; };

struct StaticOrder {
    int nM, nN, nwg, G, c, tot;
    __host__ __device__ void init(int M, int N, int G_, int c_, int repf = 1) { nM = M / BM; nN = N / BM; nwg = nM * nN; G = G_; c = c_; tot = nwg * repf; }
    __host__ __device__ bool next(int i, Unit& u) const {
        const long L = (long)i * G + c; if (L >= tot) return false;
        int wgid = (int)(L % nwg); { const int q = nwg / NXCD, r = nwg % NXCD, xcd = wgid % NXCD, off = wgid / NXCD; wgid = (xcd < r ? xcd * (q + 1) : r * (q + 1) + (xcd - r) * q) + off; }
        const int nig = WGM * nN, gid = wgid / nig, fm = gid * WGM, gsz = (nM - fm) < WGM ? (nM - fm) : WGM;
        u.pm = fm + ((wgid % nig) % gsz); u.pn = (wgid % nig) / gsz; return true;
    }
};

__device__ __forceinline__ unsigned cvt_pk_bf16(float lo, float hi) { unsigned r; asm volatile("v_cvt_pk_bf16_f32 %0, %1, %2" : "=v"(r) : "v"(lo), "v"(hi)); return r; }

template <class Epi, class Sched, bool ALIGN_EPI = false, bool SP2 = false>
__device__ __forceinline__ void gemm_phase(LAS unsigned char* lds, const Gemm g, const Sched& S, const Epi& E, int wid) {
    const int lane = fresh_lane(), tid = wid * 64 + lane, wr = wid >> 2, wc = wid & 3, fr = lane & 15, fq = lane >> 4;
    const int K = g.K, nt = K / BK;
    unsigned voffA[2], voffB[2];
#pragma unroll
    for (int i = 0; i < 2; ++i) { int R, C; stage_rc(tid * 16 + i * 8192, R, C); const int Rb = Epi::PERM ? ((R & ~31) + perm32(R & 31)) : R;
        voffA[i] = (unsigned)(R * K + C) * 2u; voffB[i] = (unsigned)(Rb * K + C) * 2u; }
    const size_t kstep = (size_t)(BK * 2);
    const size_t hstep = (size_t)HALF * K * 2;
    const size_t tstep = 2 * hstep;
    const unsigned ldsw = (unsigned)wid * 1024u;
    const int aoff = lds_byte(wr * 64 + fr, fq * 8), boff = lds_byte(wc * 32 + fr, fq * 8);
#define PG8_SA(b, h) (((b) * 2 + (h)) * HTB)
#define PG8_SB(b, h) ((4 + (b) * 2 + (h)) * HTB)
#define PG8_STAGE(bufoff, gbase, voff) do { _Pragma("unroll") for (int _i = 0; _i < 2; ++_i) \
        __builtin_amdgcn_global_load_lds((const unsigned*)((const char*)(gbase) + (voff)[_i]), (LAS unsigned*)(lds + (bufoff) + ldsw + _i * 8192), 16, 0, 0); } while (0)
#define PG8_LDA(dst, b, h) do { _Pragma("unroll") for (int m = 0; m < 4; ++m) _Pragma("unroll") for (int k = 0; k < 2; ++k) dst[m][k] = *(const LAS bf16x8*)(lds + PG8_SA(b, h) + aoff + m * 2048 + k * 1024); } while (0)
#define PG8_LDB(dst, b, h) do { _Pragma("unroll") for (int n = 0; n < 2; ++n) _Pragma("unroll") for (int k = 0; k < 2; ++k) dst[n][k] = *(const LAS bf16x8*)(lds + PG8_SB(b, h) + boff + n * 2048 + k * 1024); } while (0)
#define PG8_MMA(ai, bj, At, Bt) do { __builtin_amdgcn_s_setprio(1); _Pragma("unroll") for (int m = 0; m < 4; ++m) _Pragma("unroll") for (int n = 0; n < 2; ++n) _Pragma("unroll") for (int k = 0; k < 2; ++k) \
        acc[ai][bj][m][n] = __builtin_amdgcn_mfma_f32_16x16x32_bf16(Bt[n][k], At[m][k], acc[ai][bj][m][n], 0, 0, 0); __builtin_amdgcn_s_setprio(0); } while (0)
#define PG8_WAIT_V(n) asm volatile("s_waitcnt vmcnt(" #n ")" ::: "memory")
#define PG8_WAIT_L(n) asm volatile("s_waitcnt lgkmcnt(" #n ")" ::: "memory")
#define PG8_BAR __builtin_amdgcn_s_barrier()
#define PG8_SCHED __builtin_amdgcn_sched_barrier(0)
    Unit cur, nxt; int ui = 0;
    if (!S.next(0, cur)) return;
    f32x4 acc[2][2][4][2];
#pragma unroll
    for (int a = 0; a < 2; ++a)
#pragma unroll
        for (int b = 0; b < 2; ++b)
#pragma unroll
            for (int m = 0; m < 4; ++m)
#pragma unroll
                for (int n = 0; n < 2; ++n) acc[a][b][m][n] = (f32x4){0.f, 0.f, 0.f, 0.f};
    bf16x8 At[4][2], B0[2][2], B1[2][2];
    const char* cA = (const char*)g.A + (size_t)cur.pm * tstep; const char* cB = (const char*)g.Bt + (size_t)cur.pn * tstep;
    typename Epi::State est = E.pre(cur, wr, fr, fq);
    if constexpr (SP2) {
        PG8_STAGE(PG8_SB(0, 0), cB, voffB); PG8_STAGE(PG8_SB(0, 1), cB + hstep, voffB); PG8_STAGE(PG8_SA(0, 0), cA, voffA); PG8_STAGE(PG8_SA(0, 1), cA + hstep, voffA);
        if (wr == 1) PG8_BAR;
        PG8_WAIT_V(2); PG8_BAR;
        PG8_STAGE(PG8_SB(1, 0), cB + kstep, voffB); PG8_STAGE(PG8_SA(1, 0), cA + kstep, voffA); PG8_STAGE(PG8_SB(1, 1), cB + hstep + kstep, voffB);
        PG8_WAIT_V(6); PG8_BAR;
    } else {
        PG8_STAGE(PG8_SB(0, 0), cB, voffB); PG8_STAGE(PG8_SA(0, 0), cA, voffA); PG8_STAGE(PG8_SB(0, 1), cB + hstep, voffB); PG8_STAGE(PG8_SA(0, 1), cA + hstep, voffA);
        if (wr == 1) PG8_BAR;
        PG8_WAIT_V(4); PG8_BAR;
        PG8_STAGE(PG8_SB(1, 0), cB + kstep, voffB); PG8_STAGE(PG8_SA(1, 0), cA + kstep, voffA); PG8_STAGE(PG8_SB(1, 1), cB + hstep + kstep, voffB);
        PG8_WAIT_V(6); PG8_BAR;
    }
    for (;;) {
        const bool has_next = S.next(ui + 1, nxt);
        const char* nA = has_next ? (const char*)g.A + (size_t)nxt.pm * tstep : cA; const char* nB = has_next ? (const char*)g.Bt + (size_t)nxt.pn * tstep : cB;
        for (int t = 0; t < nt; t += 2) {
            const bool last = (t == nt - 2);
            const char* a1 = cA + (size_t)(t + 1) * kstep;
            const char* a2 = last ? nA : cA + (size_t)(t + 2) * kstep; const char* b2 = last ? nB : cB + (size_t)(t + 2) * kstep;
            const char* a3 = a2 + kstep; const char* b3 = b2 + kstep;
            if constexpr (SP2) {
            PG8_LDB(B0, 0, 0); PG8_LDB(B1, 0, 1); PG8_SCHED; PG8_LDA(At, 0, 0); PG8_STAGE(PG8_SA(1, 1), a1 + hstep, voffA);
            PG8_WAIT_V(8); PG8_WAIT_L(0); PG8_BAR; PG8_MMA(0, 0, At, B0); PG8_MMA(0, 1, At, B1); PG8_BAR; PG8_SCHED;
            PG8_LDA(At, 0, 1); PG8_STAGE(PG8_SB(0, 0), b2, voffB); PG8_STAGE(PG8_SB(0, 1), b2 + hstep, voffB); PG8_STAGE(PG8_SA(0, 0), a2, voffA);
            PG8_WAIT_V(8); PG8_WAIT_L(0); PG8_BAR; PG8_MMA(1, 0, At, B0); PG8_MMA(1, 1, At, B1); PG8_BAR; PG8_SCHED;
            PG8_LDB(B0, 1, 0); PG8_LDB(B1, 1, 1); PG8_SCHED; PG8_LDA(At, 1, 0); PG8_STAGE(PG8_SA(0, 1), a2 + hstep, voffA);
            PG8_WAIT_V(8); PG8_WAIT_L(0); PG8_BAR; PG8_MMA(0, 0, At, B0); PG8_MMA(0, 1, At, B1); PG8_BAR; PG8_SCHED;
            PG8_LDA(At, 1, 1); PG8_STAGE(PG8_SB(1, 0), b3, voffB); PG8_STAGE(PG8_SB(1, 1), b3 + hstep, voffB); PG8_STAGE(PG8_SA(1, 0), a3, voffA);
            PG8_WAIT_V(8); PG8_WAIT_L(0); PG8_BAR; PG8_MMA(1, 0, At, B0); PG8_MMA(1, 1, At, B1); PG8_BAR; PG8_SCHED;
            } else {
            PG8_LDB(B0, 0, 0); PG8_SCHED; PG8_LDA(At, 0, 0); PG8_STAGE(PG8_SA(1, 1), a1 + hstep, voffA);
            PG8_WAIT_L(8); PG8_BAR; PG8_WAIT_L(0); PG8_MMA(0, 0, At, B0); PG8_BAR; PG8_SCHED;
            PG8_LDB(B1, 0, 1); PG8_STAGE(PG8_SB(0, 0), b2, voffB);
            PG8_BAR; PG8_WAIT_L(0); PG8_MMA(0, 1, At, B1); PG8_BAR;
            PG8_LDA(At, 0, 1); PG8_STAGE(PG8_SA(0, 0), a2, voffA);
            PG8_BAR; PG8_WAIT_L(0); PG8_MMA(1, 0, At, B0); PG8_BAR; PG8_SCHED;
            PG8_STAGE(PG8_SB(0, 1), b2 + hstep, voffB);
            PG8_WAIT_V(6); PG8_BAR; PG8_MMA(1, 1, At, B1); PG8_BAR;
            PG8_LDB(B0, 1, 0); PG8_SCHED; PG8_LDA(At, 1, 0); PG8_STAGE(PG8_SA(0, 1), a2 + hstep, voffA);
            PG8_WAIT_L(8); PG8_BAR; PG8_WAIT_L(0); PG8_MMA(0, 0, At, B0); PG8_BAR; PG8_SCHED;
            PG8_LDB(B1, 1, 1); PG8_STAGE(PG8_SB(1, 0), b3, voffB);
            PG8_BAR; PG8_WAIT_L(0); PG8_MMA(0, 1, At, B1); PG8_BAR;
            PG8_LDA(At, 1, 1); PG8_STAGE(PG8_SA(1, 0), a3, voffA);
            PG8_BAR; PG8_WAIT_L(0); PG8_MMA(1, 0, At, B0); PG8_BAR; PG8_SCHED;
            PG8_STAGE(PG8_SB(1, 1), b3 + hstep, voffB);
            PG8_WAIT_V(6); PG8_BAR; PG8_MMA(1, 1, At, B1); PG8_BAR;
            }
        }
        if constexpr (ALIGN_EPI) { if (wr == 0) PG8_BAR; }
        E(acc, cur, wr, wc, fr, fq, est);
        if (!has_next) break;
#pragma unroll
        for (int a = 0; a < 2; ++a)
#pragma unroll
            for (int b = 0; b < 2; ++b)
#pragma unroll
                for (int m = 0; m < 4; ++m)
#pragma unroll
                    for (int n = 0; n < 2; ++n) acc[a][b][m][n] = (f32x4){0.f, 0.f, 0.f, 0.f};
        cur = nxt; cA = nA; cB = nB; ++ui;
        est = E.pre(cur, wr, fr, fq);
        if constexpr (ALIGN_EPI) { if (wr == 1) PG8_BAR; }
    }
    PG8_WAIT_V(0);
    if constexpr (!ALIGN_EPI) { if (wr == 0) PG8_BAR; }
    PG8_BAR;
#undef PG8_SA
#undef PG8_SB
#undef PG8_STAGE
#undef PG8_LDA
#undef PG8_LDB
#undef PG8_MMA
#undef PG8_WAIT_V
#undef PG8_WAIT_L
#undef PG8_BAR
#undef PG8_SCHED
}

struct EpiStoreBf16 {
    static constexpr bool PERM = true;
    struct State { float ss[2][4]; };
    bf16_t* O; int ldc; const float* SS;
    __device__ __forceinline__ State pre(const Unit& u, int wr, int fr, int fq) const { State st;
#pragma unroll
        for (int ai = 0; ai < 2; ++ai)
#pragma unroll
            for (int m = 0; m < 4; ++m) st.ss[ai][m] = SS[u.pm * BM + ai * HALF + wr * 64 + m * 16 + fr];
        return st; }
    __device__ __forceinline__ void operator()(const f32x4 (&acc)[2][2][4][2], const Unit& u, int wr, int wc, int fr, int fq, const State& st) const {
        const int row0 = u.pm * BM + wr * 64 + fr, col0 = u.pn * BM + wc * 32 + 8 * fq;
#pragma unroll
        for (int ai = 0; ai < 2; ++ai)
#pragma unroll
            for (int m = 0; m < 4; ++m) { bf16_t* rowp = O + (size_t)(row0 + ai * HALF + m * 16) * ldc + col0;
                const float rs = rsqrtf(st.ss[ai][m] * (1.0f / DM) + EPS);
#pragma unroll
                for (int bj = 0; bj < 2; ++bj) { const f32x4 v0 = acc[ai][bj][m][0] * rs, v1 = acc[ai][bj][m][1] * rs;
                    u32x4 w; w.x = cvt_pk_bf16(v0[0], v0[1]); w.y = cvt_pk_bf16(v0[2], v0[3]); w.z = cvt_pk_bf16(v1[0], v1[1]); w.w = cvt_pk_bf16(v1[2], v1[3]);
                    *(u32x4*)(rowp + bj * HALF) = w; } }
    }
};

struct EpiResid {
    static constexpr bool PERM = true;
    struct State {}; __device__ __forceinline__ State pre(const Unit&, int, int, int) const { return State{}; }
    const bf16_t* XB; bf16_t* XN; float* RS;
    __device__ __forceinline__ void operator()(const f32x4 (&acc)[2][2][4][2], const Unit& u, int wr, int wc, int fr, int fq, const State&) const {
        const int row0 = u.pm * BM + wr * 64 + fr, col0 = u.pn * BM + wc * 32 + 8 * fq;
#pragma unroll
        for (int ai = 0; ai < 2; ++ai)
#pragma unroll
            for (int m = 0; m < 4; ++m) { const int row = row0 + ai * HALF + m * 16; const size_t ro = (size_t)row * DM + col0; float ss = 0.f;
#pragma unroll
                for (int bj = 0; bj < 2; ++bj) {
                    const u32x4 xw = __builtin_nontemporal_load((const u32x4*)(XB + ro + bj * HALF));
                    const f32x4 x0 = (f32x4){bf_lo(xw.x), bf_hi(xw.x), bf_lo(xw.y), bf_hi(xw.y)}, x1 = (f32x4){bf_lo(xw.z), bf_hi(xw.z), bf_lo(xw.w), bf_hi(xw.w)};
                    const f32x4 v0 = acc[ai][bj][m][0] + x0, v1 = acc[ai][bj][m][1] + x1;
                    ss += (v0[0] * v0[0] + v0[1] * v0[1]) + (v0[2] * v0[2] + v0[3] * v0[3]) + (v1[0] * v1[0] + v1[1] * v1[1]) + (v1[2] * v1[2] + v1[3] * v1[3]);
                    u32x4 w; w.x = cvt_pk_bf16(v0[0], v0[1]); w.y = cvt_pk_bf16(v0[2], v0[3]); w.z = cvt_pk_bf16(v1[0], v1[1]); w.w = cvt_pk_bf16(v1[2], v1[3]);
                    *(u32x4*)(XN + ro + bj * HALF) = w; }
                ss += __shfl_xor(ss, 16); ss += __shfl_xor(ss, 32);
                if (fq == 0) atomicAdd(RS + row, ss); }
    }
};

struct EpiDown {
    static constexpr bool PERM = true;
    struct State {}; __device__ __forceinline__ State pre(const Unit&, int, int, int) const { return State{}; }
    const bf16_t* X1; float* OUT;
    __device__ __forceinline__ void operator()(const f32x4 (&acc)[2][2][4][2], const Unit& u, int wr, int wc, int fr, int fq, const State&) const {
        const int row0 = u.pm * BM + wr * 64 + fr, col0 = u.pn * BM + wc * 32 + 8 * fq;
#pragma unroll
        for (int ai = 0; ai < 2; ++ai)
#pragma unroll
            for (int m = 0; m < 4; ++m) { const size_t ro = (size_t)(row0 + ai * HALF + m * 16) * DM + col0;
#pragma unroll
                for (int bj = 0; bj < 2; ++bj) {
                    const u32x4 xw = __builtin_nontemporal_load((const u32x4*)(X1 + ro + bj * HALF));
                    const f32x4 x0 = (f32x4){bf_lo(xw.x), bf_hi(xw.x), bf_lo(xw.y), bf_hi(xw.y)}, x1 = (f32x4){bf_lo(xw.z), bf_hi(xw.z), bf_lo(xw.w), bf_hi(xw.w)};
                    __builtin_nontemporal_store(acc[ai][bj][m][0] + x0, (f32x4*)(OUT + ro + bj * HALF)); __builtin_nontemporal_store(acc[ai][bj][m][1] + x1, (f32x4*)(OUT + ro + bj * HALF + 4)); } }
    }
};

struct EpiConvAct {
    static constexpr bool PERM = true;
    struct State { float rs[4]; };
    __device__ __forceinline__ State pre(const Unit& u, int wr, int fr, int fq) const { State st;
#pragma unroll
        for (int m = 0; m < 4; ++m) st.rs[m] = RS[u.pm * BM + (fq & 1) * HALF + wr * 64 + m * 16 + fr];
        return st; }
    const float* RS; const float* CW; const float* CB; bf16_t* ACT; float* HT; float* HB; LAS unsigned char* xlds;
    __device__ __forceinline__ static int xidx(int ai, int wr, int wc, int rsel, int bj, int n, int fq) { return ((((((ai * 2 + wr) * 4 + wc) * 2 + rsel) * 2 + bj) * 2 + n) * 4 + fq); }
    __device__ __forceinline__ void operator()(const f32x4 (&acc)[2][2][4][2], const Unit& u, int wr, int wc, int fr, int fq, const State& st) const {
        asm volatile("" : "+v"(fr), "+v"(fq));
        LAS f32x4* X = (LAS f32x4*)xlds;
        LAS float* RSL = (LAS float*)(xlds + 8192) + (wr * 4 + wc) * 128;
        if (fq < 2) {
#pragma unroll
            for (int m = 0; m < 4; ++m) RSL[(fq * 4 + m) * 16 + fr] = rsqrtf(st.rs[m] * (1.0f / DM) + EPS);
        }
        asm volatile("s_waitcnt lgkmcnt(0)" ::: "memory");
        if (fr >= 14) {
#pragma unroll
            for (int ai = 0; ai < 2; ++ai) { const float r3 = RSL[(ai * 4 + 3) * 16 + fr];
#pragma unroll
                for (int bj = 0; bj < 2; ++bj)
#pragma unroll
                    for (int n = 0; n < 2; ++n) X[xidx(ai, wr, wc, fr - 14, bj, n, fq)] = acc[ai][bj][3][n] * r3; }
        }
        __syncthreads();
        const int cbase = u.pn * HALF + wc * 32 + 8 * fq;
        f32x2 W0[2][4], W1[2][4], W2[2][4], BB[2][4];
#pragma unroll
        for (int n = 0; n < 2; ++n) {
            const int c = cbase + 4 * n;
            const f32x4 wg0 = *(const f32x4*)(CW + c), wg1 = *(const f32x4*)(CW + NUP + c), wg2 = *(const f32x4*)(CW + 2 * NUP + c), bg = *(const f32x4*)(CB + c);
            const f32x4 wu0 = *(const f32x4*)(CW + DFF + c), wu1 = *(const f32x4*)(CW + NUP + DFF + c), wu2 = *(const f32x4*)(CW + 2 * NUP + DFF + c), bu = *(const f32x4*)(CB + DFF + c);
#pragma unroll
            for (int e = 0; e < 4; ++e) { W0[n][e] = (f32x2){wg0[e], wu0[e]}; W1[n][e] = (f32x2){wg1[e], wu1[e]}; W2[n][e] = (f32x2){wg2[e], wu2[e]}; BB[n][e] = (f32x2){bg[e], bu[e]}; }
        }
#pragma unroll
        for (int ai = 0; ai < 2; ++ai) {
            f32x2 pp[2][4];
#pragma unroll
            for (int n = 0; n < 2; ++n)
#pragma unroll
                for (int e = 0; e < 4; ++e) pp[n][e] = (f32x2){0.f, 0.f};
            if (wr == 1 || ai == 1) {
                const int sa = (wr == 1) ? ai : 0, sw = (wr == 1) ? 0 : 1;
                if (fr >= 14) {
#pragma unroll
                    for (int n = 0; n < 2; ++n) { const f32x4 tg = X[xidx(sa, sw, wc, fr - 14, 0, n, fq)], tu = X[xidx(sa, sw, wc, fr - 14, 1, n, fq)];
#pragma unroll
                        for (int e = 0; e < 4; ++e) pp[n][e] = (f32x2){tg[e], tu[e]}; }
                }
            }
#pragma unroll
            for (int m = 0; m < 4; ++m) {
                const float rsv = RSL[(ai * 4 + m) * 16 + fr];
                const int row = u.pm * BM + ai * HALF + wr * 64 + m * 16 + fr;
                const bool edge0 = (ai == 0 && wr == 0 && m == 0 && fr < 2);
                const bool edge1 = (ai == 1 && wr == 1 && m == 3 && fr >= 14);
                u32x4 wv;
#pragma unroll
                for (int n = 0; n < 2; ++n) {
                    const f32x4 ag = acc[ai][0][m][n], au = acc[ai][1][m][n];
                    f32x2 cur[4]; f32x4 o;
#pragma unroll
                    for (int e = 0; e < 4; ++e) {
                        cur[e] = (f32x2){ag[e], au[e]} * rsv;
                        f32x2 p1, p2;
                        p1.x = dpp_f<0x111>(dpp_f<0x121>(0.f, pp[n][e].x), cur[e].x); p1.y = dpp_f<0x111>(dpp_f<0x121>(0.f, pp[n][e].y), cur[e].y);
                        p2.x = dpp_f<0x112>(dpp_f<0x122>(0.f, pp[n][e].x), cur[e].x); p2.y = dpp_f<0x112>(dpp_f<0x122>(0.f, pp[n][e].y), cur[e].y);
                        const f32x2 v = BB[n][e] + W0[n][e] * p2 + W1[n][e] * p1 + W2[n][e] * cur[e];
                        o[e] = gelu_tanh(v.x) * v.y;
                    }
                    if (n == 0) { wv.x = cvt_pk_bf16(o[0], o[1]); wv.y = cvt_pk_bf16(o[2], o[3]); } else { wv.z = cvt_pk_bf16(o[0], o[1]); wv.w = cvt_pk_bf16(o[2], o[3]); }
                    if (edge0) {
                        *(f32x4*)(HT + ((size_t)(u.pm * 2 + fr) * 2 + 0) * DFF + cbase + 4 * n) = (f32x4){cur[0].x, cur[1].x, cur[2].x, cur[3].x};
                        *(f32x4*)(HT + ((size_t)(u.pm * 2 + fr) * 2 + 1) * DFF + cbase + 4 * n) = (f32x4){cur[0].y, cur[1].y, cur[2].y, cur[3].y}; }
                    if (edge1) {
                        *(f32x4*)(HB + ((size_t)(u.pm * 2 + fr - 14) * 2 + 0) * DFF + cbase + 4 * n) = (f32x4){cur[0].x, cur[1].x, cur[2].x, cur[3].x};
                        *(f32x4*)(HB + ((size_t)(u.pm * 2 + fr - 14) * 2 + 1) * DFF + cbase + 4 * n) = (f32x4){cur[0].y, cur[1].y, cur[2].y, cur[3].y}; }
#pragma unroll
                    for (int e = 0; e < 4; ++e) pp[n][e] = cur[e];
                }
                if (!edge0) *(u32x4*)(ACT + (size_t)row * DFF + cbase) = wv;
                __builtin_amdgcn_sched_barrier(0);
            }
        }
    }
};
}

#define XB_TMO      128
#define XB_XCNT(j)  (256  + 64 * (j))
#define XB_XSUB(j)  (1280 + 64 * (j))
#define XB_XGEN(j)  (2304 + 64 * (j))
#define XB_TOP      3328
#define XB_TOPGEN   3392
#define XCD_BAR_WORDS 3456
#define XB_SPIN_CAP (1u << 18)
__device__ __forceinline__ unsigned xb_ld(unsigned* p)              { return __hip_atomic_load(p, __ATOMIC_RELAXED, __HIP_MEMORY_SCOPE_AGENT); }
__device__ __forceinline__ unsigned xb_add(unsigned* p, unsigned v) { return __hip_atomic_fetch_add(p, v, __ATOMIC_RELAXED, __HIP_MEMORY_SCOPE_AGENT); }
__device__ __forceinline__ unsigned xb_xcc_id() { return (unsigned)__builtin_amdgcn_s_getreg((3 << 11) | 20) & 0xFu; }
#define XB_SPIN(cond, bar) do { unsigned _sp = 0; while (cond) { __builtin_amdgcn_s_sleep(1); \
    if ((++_sp & 255u) == 0u) { if (xb_ld(&(bar)[XB_TMO])) break; if (_sp > XB_SPIN_CAP) { atomicAdd(&(bar)[XB_TMO], 1u); break; } } } } while (0)
struct XcdBarrier { unsigned* bar; unsigned x; volatile LAS unsigned* st; };
__device__ __forceinline__ XcdBarrier xcd_barrier_post(unsigned* bar, volatile LAS unsigned* st) {
    XcdBarrier b; b.bar = bar; b.x = xb_xcc_id(); b.st = st;
    if (threadIdx.x == 0) (void)xb_add(&bar[XB_XCNT(b.x)], 1u);
    return b;
}
__device__ __forceinline__ void xcd_barrier_complete(unsigned* bar, unsigned x, unsigned& nloc, unsigned& nx) {
    const unsigned G = gridDim.x * gridDim.y * gridDim.z;
    unsigned sum, cnt, mine, sp = 0u;
    for (;;) {
        sum = 0u; cnt = 0u; mine = 0u;
#pragma unroll
        for (unsigned j = 0; j < 16; ++j) { const unsigned c = xb_ld(&bar[XB_XCNT(j)]); sum += c; cnt += (c > 0u) ? 1u : 0u; mine = (j == x) ? c : mine; }
        if (sum == G) break;
        __builtin_amdgcn_s_sleep(1);
        if ((++sp & 255u) == 0u) { if (xb_ld(&bar[XB_TMO])) break; if (sp > XB_SPIN_CAP) { atomicAdd(&bar[XB_TMO], 1u); break; } }
    }
    nloc = mine > 0u ? mine : 1u; nx = cnt > 0u ? cnt : 1u;
}
__device__ __forceinline__ void xcd_barrier(const XcdBarrier& b) {
    asm volatile("s_waitcnt vmcnt(0)" ::: "memory");
    __syncthreads();
    if (threadIdx.x == 0) {
        unsigned* bar = b.bar;
        __builtin_amdgcn_s_waitcnt(0);
        unsigned nloc = b.st[0], nx = b.st[1];
        if (nloc == 0u) { xcd_barrier_complete(bar, b.x, nloc, nx); b.st[0] = nloc; b.st[1] = nx; }
        const unsigned old = xb_add(&bar[XB_XSUB(b.x)], 1u);
        const unsigned gen = old / nloc;
        if (old == gen * nloc && nloc > 1u) __builtin_amdgcn_fence(__ATOMIC_RELEASE, "agent");
        if (old + 1u == (gen + 1u) * nloc) {
            __builtin_amdgcn_fence(__ATOMIC_RELEASE, "agent");
            asm volatile("s_waitcnt vmcnt(0)" ::: "memory");
            const unsigned og = xb_add(&bar[XB_TOP], 1u);
            const unsigned tg = og / nx;
            if (og + 1u == (tg + 1u) * nx) xb_add(&bar[XB_TOPGEN], 1u);
            else XB_SPIN(xb_ld(&bar[XB_TOPGEN]) == tg, bar);
            __builtin_amdgcn_fence(__ATOMIC_ACQUIRE, "agent");
            xb_add(&bar[XB_XGEN(b.x)], 1u);
            asm volatile("s_waitcnt vmcnt(0)" ::: "memory");
        } else {
            XB_SPIN(xb_ld(&bar[XB_XGEN(b.x)]) == gen, bar);
            __builtin_amdgcn_fence(__ATOMIC_ACQUIRE, "agent");
            asm volatile("s_waitcnt vmcnt(0)" ::: "memory");
        }
    }
    __syncthreads();
}

struct Args {
    const float* x; const int* pos; const float* g_mix; const float* w_in; const float* qg; const float* kg; const float* rcw; const float* rcb;
    const float* w_rg; const float* b_rg; const float* w_ig; const float* b_ig; const float* lam; const float* g_att; const float* g_rec; const float* w_out;
    const float* g_ffn; const float* w_up; const float* fcw; const float* fcb; const float* w_down;
    float* out; unsigned char* ws;
};

__device__ __forceinline__ void transpose_item(const float* W, int K, int N, bf16_t* WT, LAS float* scr, int item, int lane, const float* kscale, bool permup) {
    const int nblk = N / 32, kb = item / nblk, nb = item % nblk, k0 = 64 * kb, n0 = 32 * nb;
    float tv[32];
#pragma unroll
    for (int i = 0; i < 32; ++i) { const int kk = 2 * i + (lane >> 5); tv[i] = __builtin_nontemporal_load(W + (size_t)(k0 + kk) * N + n0 + (lane & 31)); }
#pragma unroll
    for (int i = 0; i < 32; ++i) { const int kk = 2 * i + (lane >> 5); float v = tv[i]; if (kscale) v *= kscale[k0 + kk]; scr[kk * 33 + (lane & 31)] = v; }
    asm volatile("s_waitcnt lgkmcnt(0)" ::: "memory");
    const int c = lane & 7;
#pragma unroll
    for (int j = 0; j < 4; ++j) { const int n = (lane >> 3) + 8 * j; const LAS float* s = scr + (8 * c) * 33 + n;
        u32x4 o; o.x = pk2(s[0 * 33], s[1 * 33]); o.y = pk2(s[2 * 33], s[3 * 33]); o.z = pk2(s[4 * 33], s[5 * 33]); o.w = pk2(s[6 * 33], s[7 * 33]);
        int nn = n0 + n; if (permup) { const int bjs = nn / DFF, rem = nn % DFF; nn = (rem / 128) * 256 + bjs * 128 + (rem % 128); }
        *(u32x4*)(WT + (size_t)nn * K + k0 + 8 * c) = o; }
    asm volatile("s_waitcnt lgkmcnt(0)" ::: "memory");
}

constexpr int XCS = 68;
template <bool FINAL>
__device__ __forceinline__ void lru_chunk(const Args& a, LAS unsigned char* lds, int item, int tid) {
    const int lane = tid & 63, w = __builtin_amdgcn_readfirstlane(tid >> 6), fr = lane & 15, fq = lane >> 4;
    const int b = item >> 6, c = item & 63, tok0 = b * SEQ + c * 64;
    const bf16_t* PROJ = (const bf16_t*)(a.ws + WS_PROJ);
    float* CHA = (float*)(a.ws + WS_CHS); float* CHH = CHA + 4 * 64 * 512;
    LAS float* XC = (LAS float*)lds + w * (64 * XCS);
    const float* CINB = (const float*)(a.ws + WS_HT);
    LAS float* HL = (LAS float*)(lds + 8 * 64 * XCS * 4 + 2048) + w * 192;
    {
        const int rsub = lane >> 3, c8 = lane & 7;
        const bf16_t* px = PROJ + (size_t)tok0 * NIN + 1536 + 64 * w + 8 * c8;
        u32x4 rv[9];
#pragma unroll
        for (int i = 0; i < 9; ++i) { const int row = 8 * i - 8 + rsub; rv[i] = (u32x4){0u, 0u, 0u, 0u};
            if (row >= 0 || (c > 0 && row >= -3)) rv[i] = *(const u32x4*)(px + (long)row * NIN); }
#pragma unroll
        for (int i = 0; i < 9; ++i) { const int row = 8 * i - 8 + rsub;
            const f32x4 lo = (f32x4){bf_lo(rv[i].x), bf_hi(rv[i].x), bf_lo(rv[i].y), bf_hi(rv[i].y)}, hi = (f32x4){bf_lo(rv[i].z), bf_hi(rv[i].z), bf_lo(rv[i].w), bf_hi(rv[i].w)};
            if (row >= 0) { *(LAS f32x4*)(XC + row * XCS + 8 * c8) = lo; *(LAS f32x4*)(XC + row * XCS + 8 * c8 + 4) = hi; }
            else if (row >= -3) { *(LAS f32x4*)(HL + (row + 3) * 64 + 8 * c8) = lo; *(LAS f32x4*)(HL + (row + 3) * 64 + 8 * c8 + 4) = hi; } }
    }
    asm volatile("s_waitcnt lgkmcnt(0)" ::: "memory");
    {
        const int cgl = 64 * w + lane;
        const float w0 = a.rcw[cgl], w1 = a.rcw[512 + cgl], w2 = a.rcw[1024 + cgl], w3 = a.rcw[1536 + cgl], cb = a.rcb[cgl];
        float x3 = HL[lane], x2 = HL[64 + lane], x1 = HL[128 + lane];
#pragma unroll 8
        for (int tt = 0; tt < 64; ++tt) {
            const float x0 = XC[tt * XCS + lane];
            XC[tt * XCS + lane] = cb + w0 * x3 + w1 * x2 + w2 * x1 + w3 * x0;
            x3 = x2; x2 = x1; x1 = x0;
        }
    }
    __syncthreads();
    bf16x8 af[4][2];
#pragma unroll
    for (int mt = 0; mt < 4; ++mt)
#pragma unroll
        for (int kk = 0; kk < 2; ++kk) {
            const LAS float* p = XC + (16 * mt + fr) * XCS + 32 * kk + 8 * fq;
            const f32x4 v0 = *(const LAS f32x4*)p, v1 = *(const LAS f32x4*)(p + 4);
            u32x4 pk; pk.x = pk2(v0[0], v0[1]); pk.y = pk2(v0[2], v0[3]); pk.z = pk2(v1[0], v1[1]); pk.w = pk2(v1[2], v1[3]);
            af[mt][kk] = __builtin_bit_cast(bf16x8, pk);
        }
    const bf16_t* WGT = (const bf16_t*)(a.ws + WS_WG);
    bf16x8 nbr[2], nbi[2]; float nbrg, nbig, nlam, ncin = 0.f;
    { const int chl = fr, cgl = 64 * w + chl;
#pragma unroll
        for (int kk = 0; kk < 2; ++kk) { nbr[kk] = *(const bf16x8*)(WGT + ((size_t)(w * 64 + chl) * 64 + 32 * kk + 8 * fq)); nbi[kk] = *(const bf16x8*)(WGT + 32768 + ((size_t)(w * 64 + chl) * 64 + 32 * kk + 8 * fq)); }
        nbrg = a.b_rg[cgl]; nbig = a.b_ig[cgl]; nlam = a.lam[cgl]; if (FINAL) ncin = CINB[(size_t)item * 512 + cgl]; }
#pragma unroll 1
    for (int nt = 0; nt < 4; ++nt) {
        const int chl = 16 * nt + fr, cgl = 64 * w + chl;
        const bf16x8 br0 = nbr[0], br1 = nbr[1], bi0 = nbi[0], bi1 = nbi[1];
        const float brgl = -LOG2E * nbrg, bigl = -LOG2E * nbig, cin0 = ncin;
        const float sp8 = -8.0f * log1pf(expf(-nlam));
        const float sp8l = sp8 * LOG2E, sp82 = 2.f * sp8;
        if (nt < 3) { const int chn = chl + 16, cgn = cgl + 16;
#pragma unroll
            for (int kk = 0; kk < 2; ++kk) { nbr[kk] = *(const bf16x8*)(WGT + ((size_t)(w * 64 + chn) * 64 + 32 * kk + 8 * fq)); nbi[kk] = *(const bf16x8*)(WGT + 32768 + ((size_t)(w * 64 + chn) * 64 + 32 * kk + 8 * fq)); }
            nbrg = a.b_rg[cgn]; nbig = a.b_ig[cgn]; nlam = a.lam[cgn]; if (FINAL) ncin = CINB[(size_t)item * 512 + cgn]; }
        float carry = 0.f, cumP = 1.f;
        if (FINAL) carry = cin0;
#pragma unroll
        for (int mt = 0; mt < 4; ++mt) {
            f32x4 dr = (f32x4){0.f, 0.f, 0.f, 0.f}, di = dr;
            dr = __builtin_amdgcn_mfma_f32_16x16x32_bf16(af[mt][0], br0, dr, 0, 0, 0); dr = __builtin_amdgcn_mfma_f32_16x16x32_bf16(af[mt][1], br1, dr, 0, 0, 0);
            di = __builtin_amdgcn_mfma_f32_16x16x32_bf16(af[mt][0], bi0, di, 0, 0, 0); di = __builtin_amdgcn_mfma_f32_16x16x32_bf16(af[mt][1], bi1, di, 0, 0, 0);
            float hl[4], pl[4];
#pragma unroll
            for (int j = 0; j < 4; ++j) {
                const float r = fast_rcp(1.f + fast_exp2(fmaf(dr[j], -LOG2E, brgl))), ig = fast_rcp(1.f + fast_exp2(fmaf(di[j], -LOG2E, bigl)));
                const float av = fast_exp2(sp8l * r), x2 = sp82 * r;
                const float ser = -x2 * (1.f + x2 * (0.5f + x2 * (0.16666667f + x2 * (0.041666668f + x2 * 0.0083333338f))));
                const float om = (x2 > -0.3f) ? ser : (1.f - av * av);
                const float mult = __builtin_amdgcn_sqrtf(om);
                const float xv = XC[(16 * mt + 4 * fq + j) * XCS + chl];
                const float uv = mult * ig * xv;
                if (j == 0) { hl[0] = uv; pl[0] = av; } else { hl[j] = av * hl[j - 1] + uv; pl[j] = av * pl[j - 1]; }
            }
            float IA = pl[3], IH = hl[3];
            { const float pa = __shfl_up(IA, 16), ph = __shfl_up(IH, 16); if (fq >= 1) { IH = IA * ph + IH; IA = IA * pa; } }
            { const float pa = __shfl_up(IA, 32), ph = __shfl_up(IH, 32); if (fq >= 2) { IH = IA * ph + IH; IA = IA * pa; } }
            float EA = __shfl_up(IA, 16), EH = __shfl_up(IH, 16); if (fq == 0) { EA = 1.f; EH = 0.f; }
            const float hs = EA * carry + EH, ps = EA * cumP;
            if (FINAL) {
#pragma unroll
                for (int j = 0; j < 4; ++j) XC[(16 * mt + 4 * fq + j) * XCS + chl] = pl[j] * hs + hl[j];
            }
            const float TA = __shfl(IA, 48 + fr), TH = __shfl(IH, 48 + fr);
            carry = TA * carry + TH; cumP = TA * cumP;
            (void)ps;
        }
        if (!FINAL && fq == 0) { CHA[(size_t)item * 512 + cgl] = cumP; CHH[(size_t)item * 512 + cgl] = carry; }
    }
}

constexpr int QS_B = 144, VT_B = 784;
constexpr int AQ_OFF = 0, AK_OFF = 256 * QS_B, AV_OFF = AK_OFF + 384 * QS_B;
static_assert(AV_OFF + 64 * VT_B <= MISC_OFF, "attention LDS map");
struct AttnItem { int g, b, h, c, n0; };
__device__ __forceinline__ AttnItem attn_item(int k, int G, int bid) {
    int bh, idx;
    if (G == 256) { const int x = bid & 7, j = bid >> 3, p = 32 * (k % 6) + j; bh = 4 * x + p / 48; idx = p % 48; }
    else { const int p = (bid + k * G) % 1536; bh = p / 48; idx = p % 48; }
    AttnItem it; it.g = idx >> 4; it.b = bh >> 3; it.h = bh & 7; const int cn = 2 * (idx & 15), nbk = 32 >> (2 * it.g); it.c = cn / nbk; it.n0 = cn % nbk; return it;
}
__device__ __forceinline__ void attn_load(const bf16_t* PROJ, const AttnItem it, int tid, u32x4 (&pq)[4], u32x4 (&pk)[6], u32x4 (&pv0)[3], u32x4 (&pv1)[3]) {
    const int ds = 2 * it.g, n0 = it.n0;
    const int qb = (it.b * SEQ + (128 * n0) * (1 << ds) + it.c) * NIN + it.h * 64;
    const int kb_ = (it.b * SEQ + (128 * (n0 - 1)) * (1 << ds) + it.c) * NIN + it.h * 64;
    const int rstep = NIN << ds;
#pragma unroll
    for (int i = 0; i < 4; ++i) { const int task = tid + 512 * i, row = task >> 3, ch = task & 7;
        pq[i] = *(const u32x4*)(PROJ + (qb + row * rstep + 8 * ch)); }
#pragma unroll
    for (int i = 0; i < 6; ++i) { const int task = tid + 512 * i, row = task >> 3, ch = task & 7;
        pk[i] = (u32x4){0u, 0u, 0u, 0u};
        if (n0 > 0 || row >= 128) pk[i] = *(const u32x4*)(PROJ + (kb_ + row * rstep + 512 + 8 * ch)); }
#pragma unroll
    for (int i = 0; i < 3; ++i) { const int kp = 8 * (3 * (tid >> 6) + i) + ((tid & 63) >> 3), dc = tid & 7, key = 2 * kp;
        pv0[i] = (u32x4){0u, 0u, 0u, 0u}; pv1[i] = pv0[i];
        if (n0 > 0 || key >= 128) { const int eo = kb_ + key * rstep + 1024 + 8 * dc; pv0[i] = *(const u32x4*)(PROJ + eo); pv1[i] = *(const u32x4*)(PROJ + (eo + rstep)); } }
}
__device__ __forceinline__ void attn_stage(LAS unsigned char* lds, int tid, const u32x4 (&pq)[4], const u32x4 (&pk)[6], const u32x4 (&pv0)[3], const u32x4 (&pv1)[3]) {
#pragma unroll
    for (int i = 0; i < 4; ++i) { const int task = tid + 512 * i, row = task >> 3, ch = task & 7; *(LAS u32x4*)(lds + AQ_OFF + row * QS_B + ch * 16) = pq[i]; }
#pragma unroll
    for (int i = 0; i < 6; ++i) { const int task = tid + 512 * i, row = task >> 3, ch = task & 7; *(LAS u32x4*)(lds + AK_OFF + row * QS_B + ch * 16) = pk[i]; }
#pragma unroll
    for (int i = 0; i < 3; ++i) { const int kp = 8 * (3 * (tid >> 6) + i) + ((tid & 63) >> 3), dc = tid & 7, key = 2 * kp;
        const u32x4 v0 = pv0[i], v1 = pv1[i];
        const int rr = key & 31, phys0 = (key & ~31) + 8 * ((rr & 15) >> 2) + 4 * (rr >> 4) + (rr & 3);
        const int phys = (((phys0 >> 3) ^ dc) << 3) | (phys0 & 7);
        LAS unsigned char* vb = lds + AV_OFF + (8 * dc) * VT_B + phys * 2;
        *(LAS unsigned*)(vb + 0 * VT_B) = (v0.x & 0xffffu) | (v1.x << 16); *(LAS unsigned*)(vb + 1 * VT_B) = (v0.x >> 16) | (v1.x & 0xffff0000u);
        *(LAS unsigned*)(vb + 2 * VT_B) = (v0.y & 0xffffu) | (v1.y << 16); *(LAS unsigned*)(vb + 3 * VT_B) = (v0.y >> 16) | (v1.y & 0xffff0000u);
        *(LAS unsigned*)(vb + 4 * VT_B) = (v0.z & 0xffffu) | (v1.z << 16); *(LAS unsigned*)(vb + 5 * VT_B) = (v0.z >> 16) | (v1.z & 0xffff0000u);
        *(LAS unsigned*)(vb + 6 * VT_B) = (v0.w & 0xffffu) | (v1.w << 16); *(LAS unsigned*)(vb + 7 * VT_B) = (v0.w >> 16) | (v1.w & 0xffff0000u); }
}
__device__ __forceinline__ void attn_phase(const Args& a, LAS unsigned char* lds, int G, int bid, int tid) {
    const int lane = tid & 63, w = __builtin_amdgcn_readfirstlane(tid >> 6), fr = lane & 15, fq = lane >> 4;
    const bf16_t* PROJ = (const bf16_t*)(a.ws + WS_PROJ);
    bf16_t* OB = (bf16_t*)(a.ws + WS_OB); float* LS = (float*)(a.ws + WS_LSUM);
    const float M2 = 8.0f * LOG2E * wave_max(fabsf(a.qg[lane])) * wave_max(fabsf(a.kg[lane]));
    const int nk = ((G == 256) ? 6 : (1536 - bid + G - 1) / G) * REPI_P2;
    u32x4 pq[4], pk[6], pv0[3], pv1[3];
    AttnItem cur = attn_item(0, G, bid);
    if (nk > 0) attn_load(PROJ, cur, tid, pq, pk, pv0, pv1);
    for (int k = 0; k < nk; ++k) {
        const int g = cur.g, h = cur.h, c = cur.c, n0 = cur.n0, ds = 2 * g;
        const size_t tokb = (size_t)cur.b * SEQ;
        __syncthreads();
        attn_stage(lds, tid, pq, pk, pv0, pv1);
        __syncthreads();
        if (k + 1 < nk) { cur = attn_item(k + 1, G, bid); attn_load(PROJ, cur, tid, pq, pk, pv0, pv1); }
        const int tb = w >> 2, q0 = 32 * (w & 3);
        bf16x8 qf[2][2];
#pragma unroll
        for (int qt = 0; qt < 2; ++qt)
#pragma unroll
            for (int kk = 0; kk < 2; ++kk) qf[qt][kk] = *(const LAS bf16x8*)(lds + AQ_OFF + (128 * tb + q0 + 16 * qt + fr) * QS_B + (32 * kk + 8 * fq) * 2);
        f32x4 o[2][4];
#pragma unroll
        for (int qt = 0; qt < 2; ++qt)
#pragma unroll
            for (int dt = 0; dt < 4; ++dt) o[qt][dt] = (f32x4){0.f, 0.f, 0.f, 0.f};
        float lsum[2] = {0.f, 0.f};
        const bool pad = (tb == 0 && n0 == 0);
#pragma unroll 1
        for (int blk = 0; blk < 5; ++blk) {
            const int kb = q0 + 32 * blk;
            if (pad && kb + 32 <= 128) continue;
            const int kw = 128 * tb + kb;
            bf16x8 kf[2][2], vf[4];
#pragma unroll
            for (int t = 0; t < 2; ++t)
#pragma unroll
                for (int kk = 0; kk < 2; ++kk) kf[t][kk] = *(const LAS bf16x8*)(lds + AK_OFF + (kw + 16 * t + fr) * QS_B + (32 * kk + 8 * fq) * 2);
#pragma unroll
            for (int dt = 0; dt < 4; ++dt) vf[dt] = *(const LAS bf16x8*)(lds + AV_OFF + (16 * dt + fr) * VT_B + ((((kw >> 3) + fq) ^ ((2 * dt + (fr >> 3)) & 7)) << 4));
            f32x4 s[2][2];
#pragma unroll
            for (int qt = 0; qt < 2; ++qt)
#pragma unroll
                for (int t = 0; t < 2; ++t) { s[qt][t] = (f32x4){-M2, -M2, -M2, -M2};
#pragma unroll
                    for (int kk = 0; kk < 2; ++kk) s[qt][t] = __builtin_amdgcn_mfma_f32_16x16x32_bf16(kf[t][kk], qf[qt][kk], s[qt][t], 0, 0, 0); }
            float p[2][2][4];
            if (blk >= 1 && blk <= 3) {
#pragma unroll
                for (int qt = 0; qt < 2; ++qt)
#pragma unroll
                    for (int t = 0; t < 2; ++t)
#pragma unroll
                        for (int j = 0; j < 4; ++j) { const float pv = fast_exp2(s[qt][t][j]); p[qt][t][j] = pv; lsum[qt] += pv; }
            } else {
#pragma unroll
                for (int qt = 0; qt < 2; ++qt) {
                    const int qi = q0 + 16 * qt + fr;
                    const int dlo = pad ? max(0, 128 - qi) : 0;
                    const int dbase = kb + 4 * fq - qi - dlo;
#pragma unroll
                    for (int t = 0; t < 2; ++t)
#pragma unroll
                        for (int j = 0; j < 4; ++j) { const bool valid = (unsigned)(dbase + 16 * t + j) <= (unsigned)(128 - dlo);
                            const float pv = valid ? fast_exp2(s[qt][t][j]) : 0.f; p[qt][t][j] = pv; lsum[qt] += pv; }
                }
            }
#pragma unroll
            for (int qt = 0; qt < 2; ++qt) {
                u32x4 pkd; pkd.x = pk2(p[qt][0][0], p[qt][0][1]); pkd.y = pk2(p[qt][0][2], p[qt][0][3]); pkd.z = pk2(p[qt][1][0], p[qt][1][1]); pkd.w = pk2(p[qt][1][2], p[qt][1][3]);
                const bf16x8 pb = __builtin_bit_cast(bf16x8, pkd);
#pragma unroll
                for (int dt = 0; dt < 4; ++dt) o[qt][dt] = __builtin_amdgcn_mfma_f32_16x16x32_bf16(vf[dt], pb, o[qt][dt], 0, 0, 0);
            }
        }
#pragma unroll
        for (int qt = 0; qt < 2; ++qt) {
            float ls = lsum[qt]; ls += __shfl_xor(ls, 16); ls += __shfl_xor(ls, 32);
            const float inv = 1.0f / ls;
            const size_t tq = tokb + (((size_t)(128 * (n0 + tb) + q0 + 16 * qt + fr)) << ds) + c;
            bf16_t* op = OB + ((size_t)g * MTOK + tq) * 512 + h * 64 + 4 * fq;
#pragma unroll
            for (int dt = 0; dt < 4; ++dt) { u32x2 wv; wv.x = pk2(o[qt][dt][0] * inv, o[qt][dt][1] * inv); wv.y = pk2(o[qt][dt][2] * inv, o[qt][dt][3] * inv); *(u32x2*)(op + 16 * dt) = wv; }
            if (fq == 0) LS[((size_t)g * MTOK + tq) * 8 + h] = ls;
        }
    }
}

__global__ void __launch_bounds__(512, 2) fwd_kernel(Args a) {
    extern __shared__ __attribute__((aligned(16))) unsigned char lds_raw[];
    LAS unsigned char* lds = (LAS unsigned char*)lds_raw;
    cg::grid_group grid = cg::this_grid();
    const int wave = __builtin_amdgcn_readfirstlane(threadIdx.x >> 6);
    const int G = gridDim.x, bid = blockIdx.x;
#define FRESH_TID() const int lane = fresh_lane(), tid = wave * 64 + lane; (void)tid; (void)lane
    const int gw = bid * 8 + wave, NGW = G * 8;
    unsigned char* ws = a.ws;
    bf16_t* WIN = (bf16_t*)(ws + WS_WIN); bf16_t* WOUT = (bf16_t*)(ws + WS_WOUT); bf16_t* WDN = (bf16_t*)(ws + WS_WDN); bf16_t* WUP = (bf16_t*)(ws + WS_WUP);
    bf16_t* XN = (bf16_t*)(ws + WS_XN); bf16_t* PROJ = (bf16_t*)(ws + WS_PROJ); bf16_t* MIX = (bf16_t*)(ws + WS_MIX); bf16_t* ACT = (bf16_t*)(ws + WS_ACT);
    bf16_t* OB = (bf16_t*)(ws + WS_OB); float* LS = (float*)(ws + WS_LSUM);
    unsigned* BARW = (unsigned*)(ws + WS_BAR); bf16_t* WGT = (bf16_t*)(ws + WS_WG);
    if (threadIdx.x < 2) ((volatile LAS unsigned*)(lds + MISC_OFF))[threadIdx.x] = 0u;
    __syncthreads();
    (void)xcd_barrier_post(BARW, (volatile LAS unsigned*)(lds + MISC_OFF));
#define GSYNC() do { XcdBarrier xb_; xb_.bar = (unsigned*)(a.ws + WS_BAR); xb_.x = xb_xcc_id(); xb_.st = (volatile LAS unsigned*)(lds + MISC_OFF); xcd_barrier(xb_); } while (0)
    float* RS = (float*)(ws + WS_RS); float* RS0 = (float*)(ws + WS_RS0); f32x2* CS = (f32x2*)(ws + WS_CS); float* HT = (float*)(ws + WS_HT); float* HB = (float*)(ws + WS_HB);

    for (int rep = 0; rep < REP_P0; ++rep) {
        if (rep) GSYNC();
        FRESH_TID();
        LAS float* scr = (LAS float*)(lds + wave * 16384);
        constexpr int I_IN = (DM / 64) * (NIN / 32);
        for (int it = gw; it < I_IN; it += NGW) transpose_item(a.w_in, DM, NIN, WIN, scr, it, lane, a.g_mix, false);
        {
            for (int m0 = gw * 4; m0 < MTOK; m0 += NGW * 4) {
                f32x4 v[4][4];
#pragma unroll
                for (int q = 0; q < 4; ++q) { const f32x4* xr = (const f32x4*)(a.x + (size_t)(m0 + q) * DM) + lane;
#pragma unroll
                    for (int j = 0; j < 4; ++j) v[q][j] = __builtin_nontemporal_load(xr + 64 * j); }
#pragma unroll
                for (int q = 0; q < 4; ++q) { float s = 0.f;
#pragma unroll
                    for (int j = 0; j < 4; ++j) s += (v[q][j][0] * v[q][j][0] + v[q][j][1] * v[q][j][1]) + (v[q][j][2] * v[q][j][2] + v[q][j][3] * v[q][j][3]);
                    const float ssum = wave_sum(s);
                    if (lane == 0) RS0[m0 + q] = ssum;
                    u32x2* o8 = (u32x2*)(XN + (size_t)(m0 + q) * DM) + lane;
#pragma unroll
                    for (int j = 0; j < 4; ++j) { u32x2 wv; wv.x = pk2(v[q][j][0], v[q][j][1]); wv.y = pk2(v[q][j][2], v[q][j][3]); o8[64 * j] = wv; } }
            }
        }
        for (int idx = bid * 512 + tid; idx < MTOK * 32; idx += G * 512) {
            const int tok = idx >> 5, i = idx & 31;
            const float invf = powf(10000.0f, -(float)i * (1.0f / 32.0f));
            const float ang = (float)a.pos[tok] * invf;
            const float kq = rintf(ang * 0.15915494309189535f);
            float rr = fmaf(-kq, 6.2831854820251465f, ang); rr = fmaf(-kq, -1.7484556000744883e-07f, rr);
            CS[idx] = (f32x2){__cosf(rr), __sinf(rr)};
        }
        for (int idx = bid * 512 + tid; idx < 2 * 8 * 64 * 64; idx += G * 512) {
            const int in = idx & 63, out = (idx >> 6) & 63, n = (idx >> 12) & 7, mat = idx >> 15;
            WGT[idx] = (bf16_t)f2bf((mat ? a.w_ig : a.w_rg)[(n * 64 + in) * 64 + out]);
        }
    }
    if (a.ws == nullptr) grid.sync();
    GSYNC();
#define GSYNC_UNUSED() do { XcdBarrier xb_; xb_.bar = (unsigned*)(a.ws + WS_BAR); xb_.x = xb_xcc_id(); xb_.st = (volatile LAS unsigned*)(lds + MISC_OFF); xcd_barrier(xb_); } while (0)
    for (int rep = 0; rep < REP_SYNC; ++rep) GSYNC();

    for (int rep = 0; rep < REP_P1; ++rep) {
        if (rep) GSYNC();
        pg8::Gemm g{XN, WIN, MTOK, NIN, DM}; pg8::StaticOrder S; S.init(MTOK, NIN, G, bid, REPG_P1);
        pg8::EpiStoreBf16 E{PROJ, NIN, RS0};
        pg8::gemm_phase<pg8::EpiStoreBf16, pg8::StaticOrder, true, true>(lds, g, S, E, wave);
        if (rep == 0) {
            FRESH_TID();
            constexpr int NU = (MTOK / 256) * (NIN / 256) * REPG_P1;
            const int rem = NU % G, first = rem, nwg = G - first;
            if (bid >= first) {
                LAS float* scr = (LAS float*)(lds + wave * 16384);
                constexpr int I_OUT = (DM / 64) * (DM / 32), I_UP = (DM / 64) * (NUP / 32), I_DN = (DFF / 64) * (DM / 32);
                for (int it = (bid - first) * 8 + wave; it < I_OUT + I_UP + I_DN; it += nwg * 8) {
                    int r = it;
                    if (r < I_OUT) { transpose_item(a.w_out, DM, DM, WOUT, scr, r, lane, nullptr, false); continue; } r -= I_OUT;
                    if (r < I_UP) { transpose_item(a.w_up, DM, NUP, WUP, scr, r, lane, a.g_ffn, true); continue; } r -= I_UP;
                    transpose_item(a.w_down, DFF, DM, WDN, scr, r, lane, nullptr, false);
                }
            }
        }
    }
    GSYNC();

    {
        FRESH_TID();
        for (int rep = 0; rep < REP_LRUA; ++rep) { if (rep) GSYNC();
        for (int item = bid; item < 256; item += G) { __syncthreads(); lru_chunk<false>(a, lds, item, tid); } }
        {
            const int d0 = 8 * (lane & 7);
            const bool hi = (lane & 4) != 0;
            float gq[8], gk[8];
#pragma unroll
            for (int j = 0; j < 8; ++j) { gq[j] = a.qg[d0 + j] * (0.125f * LOG2E); gk[j] = a.kg[d0 + j]; }
            for (int tok0 = gw * 4; tok0 < MTOK; tok0 += NGW * 4) {
                u32x4 rq[4], rk[4]; f32x4 csv[4][4];
#pragma unroll
                for (int q = 0; q < 4; ++q) { const bf16_t* pq = PROJ + (size_t)(tok0 + q) * NIN + 8 * lane; rq[q] = *(const u32x4*)pq; rk[q] = *(const u32x4*)(pq + 512);
                    const f32x4* cs4 = (const f32x4*)(CS + (size_t)(tok0 + q) * 32 + 8 * (lane & 3));
#pragma unroll
                    for (int j = 0; j < 4; ++j) csv[q][j] = __builtin_nontemporal_load(cs4 + j); }
#pragma unroll
                for (int q = 0; q < 4; ++q) {
                    float qv[8], kv[8];
                    qv[0] = bf_lo(rq[q].x); qv[1] = bf_hi(rq[q].x); qv[2] = bf_lo(rq[q].y); qv[3] = bf_hi(rq[q].y); qv[4] = bf_lo(rq[q].z); qv[5] = bf_hi(rq[q].z); qv[6] = bf_lo(rq[q].w); qv[7] = bf_hi(rq[q].w);
                    kv[0] = bf_lo(rk[q].x); kv[1] = bf_hi(rk[q].x); kv[2] = bf_lo(rk[q].y); kv[3] = bf_hi(rk[q].y); kv[4] = bf_lo(rk[q].z); kv[5] = bf_hi(rk[q].z); kv[6] = bf_lo(rk[q].w); kv[7] = bf_hi(rk[q].w);
                    float sq = 0.f, sk = 0.f;
#pragma unroll
                    for (int j = 0; j < 8; ++j) { sq += qv[j] * qv[j]; sk += kv[j] * kv[j]; }
                    sq += __shfl_xor(sq, 1); sq += __shfl_xor(sq, 2); sq += __shfl_xor(sq, 4);
                    sk += __shfl_xor(sk, 1); sk += __shfl_xor(sk, 2); sk += __shfl_xor(sk, 4);
                    const float rq_ = rsqrtf(sq * (1.f / 64.f) + EPS), rk_ = rsqrtf(sk * (1.f / 64.f) + EPS);
                    float oq[8], ok[8];
#pragma unroll
                    for (int j = 0; j < 8; ++j) {
                        const float qn = qv[j] * rq_ * gq[j], kn = kv[j] * rk_ * gk[j];
                        const float qp = __shfl_xor(qn, 4), kp = __shfl_xor(kn, 4);
                        const float cc = csv[q][j >> 1][2 * (j & 1)], sn = csv[q][j >> 1][2 * (j & 1) + 1];
                        oq[j] = hi ? (qn * cc + qp * sn) : (qn * cc - qp * sn);
                        ok[j] = hi ? (kn * cc + kp * sn) : (kn * cc - kp * sn);
                    }
                    u32x4 wq, wk; wq.x = pk2(oq[0], oq[1]); wq.y = pk2(oq[2], oq[3]); wq.z = pk2(oq[4], oq[5]); wq.w = pk2(oq[6], oq[7]);
                    wk.x = pk2(ok[0], ok[1]); wk.y = pk2(ok[2], ok[3]); wk.z = pk2(ok[4], ok[5]); wk.w = pk2(ok[6], ok[7]);
                    bf16_t* pq = PROJ + (size_t)(tok0 + q) * NIN + 8 * lane;
                    *(u32x4*)pq = wq; *(u32x4*)(pq + 512) = wk;
                }
            }
        }
    }
    GSYNC();

    {
        FRESH_TID();
        float* CINB = HT;
        const float* CHA = (const float*)(ws + WS_CHS); const float* CHH = CHA + 4 * 64 * 512;
        for (int p = gw; p < 4 * 512; p += NGW) {
            const int b = p >> 9, ch = p & 511; const size_t o = ((size_t)(b * 64 + lane)) * 512 + ch;
            float IA = CHA[o], IH = CHH[o];
#pragma unroll
            for (int off = 1; off < 64; off <<= 1) { const float pa = __shfl_up(IA, off), ph = __shfl_up(IH, off); if (lane >= off) { IH = IA * ph + IH; IA = IA * pa; } }
            float EH = __shfl_up(IH, 1); if (lane == 0) EH = 0.f;
            CINB[o] = EH;
        }
    }
    for (int rep = 0; rep < REP_P2; ++rep) { FRESH_TID(); attn_phase(a, lds, G, bid, tid); GSYNC(); }

    for (int rep = 0; rep < REP_P3; ++rep) { if (rep) GSYNC();
    FRESH_TID();
    for (int item = bid; item < 256; item += G) {
        __syncthreads();
        lru_chunk<true>(a, lds, item, tid);
        __syncthreads();
        const int tok0 = (item >> 6) * SEQ + (item & 63) * 64;
        const int nb = lane >> 3, c8 = 8 * (lane & 7);
        const f32x4 gr0 = *(const f32x4*)(a.g_rec + 8 * lane), gr1 = *(const f32x4*)(a.g_rec + 8 * lane + 4);
        const f32x4 ga0 = *(const f32x4*)(a.g_att + 8 * lane), ga1 = *(const f32x4*)(a.g_att + 8 * lane + 4);
        {
            u32x4 gwv[8];
#pragma unroll
            for (int ti = 0; ti < 8; ++ti) gwv[ti] = __builtin_nontemporal_load((const u32x4*)(PROJ + ((size_t)tok0 + 8 * wave + ti) * NIN + 2048 + 8 * lane));
#pragma unroll
            for (int ti = 0; ti < 8; ++ti) {
                const int tt = 8 * wave + ti; const size_t tok = (size_t)tok0 + tt;
                const LAS float* hp = (const LAS float*)lds + nb * (64 * XCS) + tt * XCS + c8;
                const f32x4 h0 = *(const LAS f32x4*)hp, h1 = *(const LAS f32x4*)(hp + 4);
                const u32x4 gw_ = gwv[ti];
                float rv[8];
                rv[0] = h0[0] * gelu_tanh(bf_lo(gw_.x)); rv[1] = h0[1] * gelu_tanh(bf_hi(gw_.x)); rv[2] = h0[2] * gelu_tanh(bf_lo(gw_.y)); rv[3] = h0[3] * gelu_tanh(bf_hi(gw_.y));
                rv[4] = h1[0] * gelu_tanh(bf_lo(gw_.z)); rv[5] = h1[1] * gelu_tanh(bf_hi(gw_.z)); rv[6] = h1[2] * gelu_tanh(bf_lo(gw_.w)); rv[7] = h1[3] * gelu_tanh(bf_hi(gw_.w));
                float ss = 0.f;
#pragma unroll
                for (int j = 0; j < 8; ++j) ss += rv[j] * rv[j];
                const float rn = rsqrtf(wave_sum(ss) * (1.f / 512.f) + EPS);
                u32x4 wr_; wr_.x = pk2(rv[0] * rn * gr0[0], rv[1] * rn * gr0[1]); wr_.y = pk2(rv[2] * rn * gr0[2], rv[3] * rn * gr0[3]);
                wr_.z = pk2(rv[4] * rn * gr1[0], rv[5] * rn * gr1[1]); wr_.w = pk2(rv[6] * rn * gr1[2], rv[7] * rn * gr1[3]);
                *(u32x4*)(MIX + tok * DM + 512 + 8 * lane) = wr_;
            }
#pragma unroll
            for (int th = 0; th < 2; ++th) {
                u32x4 ov[4][3]; float lg[4][3];
#pragma unroll
                for (int q = 0; q < 4; ++q) { const size_t tok = (size_t)tok0 + 8 * wave + 4 * th + q;
#pragma unroll
                    for (int g = 0; g < 3; ++g) { lg[q][g] = __builtin_nontemporal_load(LS + ((size_t)g * MTOK + tok) * 8 + nb); ov[q][g] = __builtin_nontemporal_load((const u32x4*)(OB + ((size_t)g * MTOK + tok) * 512 + 8 * lane)); } }
#pragma unroll
                for (int q = 0; q < 4; ++q) { const size_t tok = (size_t)tok0 + 8 * wave + 4 * th + q;
                    float av[8]; float lt = 0.f;
#pragma unroll
                    for (int j = 0; j < 8; ++j) av[j] = 0.f;
#pragma unroll
                    for (int g = 0; g < 3; ++g) { const float l_ = lg[q][g]; const u32x4 o_ = ov[q][g]; lt += l_;
                        av[0] += l_ * bf_lo(o_.x); av[1] += l_ * bf_hi(o_.x); av[2] += l_ * bf_lo(o_.y); av[3] += l_ * bf_hi(o_.y);
                        av[4] += l_ * bf_lo(o_.z); av[5] += l_ * bf_hi(o_.z); av[6] += l_ * bf_lo(o_.w); av[7] += l_ * bf_hi(o_.w); }
                    const float il = 1.0f / lt; float sa = 0.f;
#pragma unroll
                    for (int j = 0; j < 8; ++j) { av[j] *= il; sa += av[j] * av[j]; }
                    const float an = rsqrtf(wave_sum(sa) * (1.f / 512.f) + EPS);
                    u32x4 wa; wa.x = pk2(av[0] * an * ga0[0], av[1] * an * ga0[1]); wa.y = pk2(av[2] * an * ga0[2], av[3] * an * ga0[3]);
                    wa.z = pk2(av[4] * an * ga1[0], av[5] * an * ga1[1]); wa.w = pk2(av[6] * an * ga1[2], av[7] * an * ga1[3]);
                    *(u32x4*)(MIX + tok * DM + 8 * lane) = wa;
                }
            }
        }
    } }
    GSYNC();

    {
        pg8::Gemm g{MIX, WOUT, MTOK, DM, DM}; pg8::StaticOrder S; S.init(MTOK, DM, G, bid);
        pg8::EpiResid E{XN, XN, RS};
        pg8::gemm_phase<pg8::EpiResid, pg8::StaticOrder, true, true>(lds, g, S, E, wave);
    }
    GSYNC();

    for (int rep = 0; rep < REP_P5; ++rep) {
        if (rep) GSYNC();
        pg8::Gemm g{XN, WUP, MTOK, NUP, DM}; pg8::StaticOrder S; S.init(MTOK, NUP, G, bid, REPG_P5);
        pg8::EpiConvAct E{RS, a.fcw, a.fcb, ACT, HT, HB, lds + XLDS_OFF};
        pg8::gemm_phase<pg8::EpiConvAct, pg8::StaticOrder, true, true>(lds, g, S, E, wave);
    }
    GSYNC();

    {
        FRESH_TID();
        pg8::StaticOrder S0; S0.init(MTOK, DM, G, bid); pg8::Unit u0;
        for (int ui = 0; S0.next(ui, u0); ++ui) {
            const int pm = u0.pm;
            for (int v = tid; v < DFF / 4; v += 512) {
                const int c = 4 * v;
                f32x4 cv[2][2];
#pragma unroll
                for (int bj = 0; bj < 2; ++bj) {
                    const f32x4 t0 = *(const f32x4*)(HT + ((size_t)(pm * 2 + 0) * 2 + bj) * DFF + c), t1 = *(const f32x4*)(HT + ((size_t)(pm * 2 + 1) * 2 + bj) * DFF + c);
                    f32x4 b0 = (f32x4){0.f, 0.f, 0.f, 0.f}, b1 = b0;
                    if ((pm & 15) != 0) { b0 = *(const f32x4*)(HB + ((size_t)((pm - 1) * 2 + 0) * 2 + bj) * DFF + c); b1 = *(const f32x4*)(HB + ((size_t)((pm - 1) * 2 + 1) * 2 + bj) * DFF + c); }
                    const int col = bj * DFF + c;
                    const f32x4 w0 = *(const f32x4*)(a.fcw + col), w1 = *(const f32x4*)(a.fcw + NUP + col), w2 = *(const f32x4*)(a.fcw + 2 * NUP + col), bb = *(const f32x4*)(a.fcb + col);
                    cv[bj][0] = bb + w0 * b0 + w1 * b1 + w2 * t0;
                    cv[bj][1] = bb + w0 * b1 + w1 * t0 + w2 * t1;
                }
#pragma unroll
                for (int rr = 0; rr < 2; ++rr) { u32x2 wv;
                    wv.x = pk2(gelu_tanh(cv[0][rr][0]) * cv[1][rr][0], gelu_tanh(cv[0][rr][1]) * cv[1][rr][1]);
                    wv.y = pk2(gelu_tanh(cv[0][rr][2]) * cv[1][rr][2], gelu_tanh(cv[0][rr][3]) * cv[1][rr][3]);
                    *(u32x2*)(ACT + (size_t)(pm * 256 + rr) * DFF + c) = wv; }
            }
        }
        asm volatile("s_waitcnt vmcnt(0)" ::: "memory");
        __syncthreads();
    }

    {
        pg8::Gemm g{ACT, WDN, MTOK, DM, DFF}; pg8::StaticOrder S; S.init(MTOK, DM, G, bid);
        pg8::EpiDown E{XN, a.out};
        pg8::gemm_phase<pg8::EpiDown, pg8::StaticOrder, true, true>(lds, g, S, E, wave);
    }
    (void)OB; (void)LS;
}

extern "C" void kernel_launch(void* const* d_in, const int* in_sizes, int n_in, void* d_out, int out_size, void* d_ws, size_t ws_size, hipStream_t stream) {
    static int grid_blocks = 0;
    if (grid_blocks == 0) {
        if (n_in != 21 || ws_size < WS_END) { fprintf(stderr, "kernel_launch: unexpected inputs (n_in %d, ws %zu)\n", n_in, ws_size); grid_blocks = -1; return; }
        int dev = 0, cus = 0, per_cu = 0;
        hipGetDevice(&dev);
        hipDeviceGetAttribute(&cus, hipDeviceAttributeMultiprocessorCount, dev);
        hipFuncSetAttribute((const void*)fwd_kernel, hipFuncAttributeMaxDynamicSharedMemorySize, LDS_BYTES);
        hipOccupancyMaxActiveBlocksPerMultiprocessor(&per_cu, (const void*)fwd_kernel, 512, LDS_BYTES);
        if (per_cu < 1) per_cu = 1;
        grid_blocks = cus * per_cu;
        if (grid_blocks > 256) grid_blocks = 256;
        (void)hipGetLastError();
    }
    if (grid_blocks < 0) return;
    Args a{};
    a.x = (const float*)d_in[0]; a.pos = (const int*)d_in[1]; a.g_mix = (const float*)d_in[2]; a.w_in = (const float*)d_in[3];
    a.qg = (const float*)d_in[4]; a.kg = (const float*)d_in[5]; a.rcw = (const float*)d_in[6]; a.rcb = (const float*)d_in[7];
    a.w_rg = (const float*)d_in[8]; a.b_rg = (const float*)d_in[9]; a.w_ig = (const float*)d_in[10]; a.b_ig = (const float*)d_in[11];
    a.lam = (const float*)d_in[12]; a.g_att = (const float*)d_in[13]; a.g_rec = (const float*)d_in[14]; a.w_out = (const float*)d_in[15];
    a.g_ffn = (const float*)d_in[16]; a.w_up = (const float*)d_in[17]; a.fcw = (const float*)d_in[18]; a.fcb = (const float*)d_in[19];
    a.w_down = (const float*)d_in[20];
    a.out = (float*)d_out; a.ws = (unsigned char*)d_ws;
    (void)hipMemsetAsync(d_ws, 0, WS_ZERO_BYTES, stream);
    void* args[] = {&a};
    hipError_t e = hipLaunchCooperativeKernel((const void*)fwd_kernel, dim3(grid_blocks), dim3(512), args, LDS_BYTES, stream);
    if (e != hipSuccess) fprintf(stderr, "cooperative launch failed: %s (grid %d)\n", hipGetErrorString(e), grid_blocks);
}
```

```cpp
#include <hip/hip_runtime.h>
#include <hip/hip_cooperative_groups.h>
#include <cstdio>
#include <cstdint>
namespace cg = cooperative_groups;
#ifndef REP_SYNC
#define REP_SYNC 0
#endif
#ifndef REP_P0
#define REP_P0 1
#endif
#ifndef REP_P1
#define REP_P1 1
#endif
#ifndef REP_LRUA
#define REP_LRUA 1
#endif
#ifndef REP_P2
#define REP_P2 1
#endif
#ifndef REP_P3
#define REP_P3 1
#endif
#ifndef REP_P5
#define REP_P5 1
#endif
#ifndef REPG_P1
#define REPG_P1 1
#endif
#ifndef REPG_P5
#define REPG_P5 1
#endif
#ifndef REPI_P2
#define REPI_P2 1
#endif

#define LAS __attribute__((address_space(3)))
typedef unsigned short bf16_t;
typedef short bf16x8 __attribute__((ext_vector_type(8)));
typedef float f32x4 __attribute__((ext_vector_type(4)));
typedef float f32x2 __attribute__((ext_vector_type(2)));
typedef unsigned u32x4 __attribute__((ext_vector_type(4)));
typedef unsigned u32x2 __attribute__((ext_vector_type(2)));

constexpr int MTOK = 16384, SEQ = 4096, DM = 1024, NIN = 2560, DFF = 3072, NUP = 6144;
constexpr float EPS = 1e-6f;
constexpr float LOG2E = 1.4426950408889634f;

constexpr size_t MiB = 1u << 20;
constexpr size_t WS_RS = 0;
constexpr size_t WS_BAR = 65536;
constexpr size_t WS_RS0 = 262144;
constexpr size_t WS_CHS = 1 * MiB;
constexpr size_t WS_CS = 2 * MiB;
constexpr size_t WS_LSUM = 6 * MiB;
constexpr size_t WS_WG = 7 * MiB + 512 * 1024;
constexpr size_t WS_ZERO_BYTES = 131072;
constexpr size_t WS_WIN = 8 * MiB;
constexpr size_t WS_WOUT = 13 * MiB;
constexpr size_t WS_WDN = 15 * MiB;
constexpr size_t WS_WUP = 21 * MiB;
constexpr size_t WS_HT = 33 * MiB;
constexpr size_t WS_HB = 36 * MiB;
constexpr size_t WS_XN = 40 * MiB;
constexpr size_t WS_PROJ = 72 * MiB;
constexpr size_t WS_OB = 152 * MiB;
constexpr size_t WS_MIX = 200 * MiB;
constexpr size_t WS_ACT = 72 * MiB;
constexpr size_t WS_END = 232 * MiB;

constexpr int LDS_BYTES = 155648;
constexpr int XLDS_OFF = 131072;
constexpr int MISC_OFF = 155648 - 64;

__device__ __forceinline__ unsigned f2bf(float f) { unsigned u = __builtin_bit_cast(unsigned, f); return (u + 0x7fffu + ((u >> 16) & 1u)) >> 16; }
__device__ __forceinline__ unsigned pk2(float lo, float hi) { unsigned r; asm("v_cvt_pk_bf16_f32 %0, %1, %2" : "=v"(r) : "v"(lo), "v"(hi)); return r; }
__device__ __forceinline__ float bf_lo(unsigned w) { return __builtin_bit_cast(float, w << 16); }
__device__ __forceinline__ float bf_hi(unsigned w) { return __builtin_bit_cast(float, w & 0xffff0000u); }
__device__ __forceinline__ float bf2f(bf16_t h) { return __builtin_bit_cast(float, (unsigned)h << 16); }
__device__ __forceinline__ float fast_exp2(float x) { return __builtin_amdgcn_exp2f(x); }
__device__ __forceinline__ float fast_rcp(float x) { return __builtin_amdgcn_rcpf(x); }
__device__ __forceinline__ float sigmoidf_(float z) { return fast_rcp(1.f + fast_exp2(-z * LOG2E)); }
__device__ __forceinline__ float gelu_tanh(float x) { const float t = x * fmaf(x * x, -2.f * LOG2E * 0.7978845608028654f * 0.044715f, -2.f * LOG2E * 0.7978845608028654f); return x * fast_rcp(1.f + fast_exp2(t)); }
__device__ __forceinline__ float wave_sum(float v) {
#pragma unroll
    for (int o = 1; o < 64; o <<= 1) v += __shfl_xor(v, o);
    return v;
}
__device__ __forceinline__ float wave_max(float v) {
#pragma unroll
    for (int o = 1; o < 64; o <<= 1) v = fmaxf(v, __shfl_xor(v, o));
    return v;
}
__device__ __forceinline__ int fresh_lane() { int l; asm volatile("v_mbcnt_lo_u32_b32 %0, -1, 0\n\tv_mbcnt_hi_u32_b32 %0, -1, %0" : "=v"(l)); return l; }
template <int CTRL> __device__ __forceinline__ float dpp_f(float old, float src) {
    return __builtin_bit_cast(float, __builtin_amdgcn_update_dpp(__builtin_bit_cast(int, old), __builtin_bit_cast(int, src), CTRL, 0xF, 0xF, false));
}

namespace pg8 {
constexpr int BM = 256, BK = 64, HALF = 128, HTB = HALF * BK * 2, STAGE_BYTES = 8 * HTB, NXCD = 8, WGM = 8;
__host__ __device__ __forceinline__ int lds_byte(int r, int c) { const int st = (r >> 4) * 2 + (c >> 5), rr = r & 15, cc = c & 31, ob = rr * 64 + cc * 2; return st * 1024 + (ob ^ (((ob >> 9) & 1) << 5)); }
__host__ __device__ __forceinline__ void stage_rc(int b, int& R, int& C) { const int st = b / 1024, sb = b % 1024, swz = sb ^ (((sb >> 9) & 1) << 5); R = (st >> 1) * 16 + swz / 64; C = (st & 1) * 32 + (swz % 64) / 2; }
__host__ __device__ __forceinline__ int perm32(int rho) { const int n = rho >> 4, i = rho & 15; return 8 * (i >> 2) + 4 * n + (i & 3); }

struct Unit { int pm, pn; };
struct Gemm { const bf16_t* A; const bf16_t* Bt; int M, N, K; };

struct StaticOrder {
    int nM, nN, nwg, G, c, tot;
    __host__ __device__ void init(int M, int N, int G_, int c_, int repf = 1) { nM = M / BM; nN = N / BM; nwg = nM * nN; G = G_; c = c_; tot = nwg * repf; }
    __host__ __device__ bool next(int i, Unit& u) const {
        const long L = (long)i * G + c; if (L >= tot) return false;
        int wgid = (int)(L % nwg); { const int q = nwg / NXCD, r = nwg % NXCD, xcd = wgid % NXCD, off = wgid / NXCD; wgid = (xcd < r ? xcd * (q + 1) : r * (q + 1) + (xcd - r) * q) + off; }
        const int nig = WGM * nN, gid = wgid / nig, fm = gid * WGM, gsz = (nM - fm) < WGM ? (nM - fm) : WGM;
        u.pm = fm + ((wgid % nig) % gsz); u.pn = (wgid % nig) / gsz; return true;
    }
};

__device__ __forceinline__ unsigned cvt_pk_bf16(float lo, float hi) { unsigned r; asm volatile("v_cvt_pk_bf16_f32 %0, %1, %2" : "=v"(r) : "v"(lo), "v"(hi)); return r; }

template <class Epi, class Sched, bool ALIGN_EPI = false, bool SP2 = false>
__device__ __forceinline__ void gemm_phase(LAS unsigned char* lds, const Gemm g, const Sched& S, const Epi& E, int wid) {
    const int lane = fresh_lane(), tid = wid * 64 + lane, wr = wid >> 2, wc = wid & 3, fr = lane & 15, fq = lane >> 4;
    const int K = g.K, nt = K / BK;
    unsigned voffA[2], voffB[2];
#pragma unroll
    for (int i = 0; i < 2; ++i) { int R, C; stage_rc(tid * 16 + i * 8192, R, C); const int Rb = Epi::PERM ? ((R & ~31) + perm32(R & 31)) : R;
        voffA[i] = (unsigned)(R * K + C) * 2u; voffB[i] = (unsigned)(Rb * K + C) * 2u; }
    const size_t kstep = (size_t)(BK * 2);
    const size_t hstep = (size_t)HALF * K * 2;
    const size_t tstep = 2 * hstep;
    const unsigned ldsw = (unsigned)wid * 1024u;
    const int aoff = lds_byte(wr * 64 + fr, fq * 8), boff = lds_byte(wc * 32 + fr, fq * 8);
#define PG8_SA(b, h) (((b) * 2 + (h)) * HTB)
#define PG8_SB(b, h) ((4 + (b) * 2 + (h)) * HTB)
#define PG8_STAGE(bufoff, gbase, voff) do { _Pragma("unroll") for (int _i = 0; _i < 2; ++_i) \
        __builtin_amdgcn_global_load_lds((const unsigned*)((const char*)(gbase) + (voff)[_i]), (LAS unsigned*)(lds + (bufoff) + ldsw + _i * 8192), 16, 0, 0); } while (0)
#define PG8_LDA(dst, b, h) do { _Pragma("unroll") for (int m = 0; m < 4; ++m) _Pragma("unroll") for (int k = 0; k < 2; ++k) dst[m][k] = *(const LAS bf16x8*)(lds + PG8_SA(b, h) + aoff + m * 2048 + k * 1024); } while (0)
#define PG8_LDB(dst, b, h) do { _Pragma("unroll") for (int n = 0; n < 2; ++n) _Pragma("unroll") for (int k = 0; k < 2; ++k) dst[n][k] = *(const LAS bf16x8*)(lds + PG8_SB(b, h) + boff + n * 2048 + k * 1024); } while (0)
#define PG8_MMA(ai, bj, At, Bt) do { __builtin_amdgcn_s_setprio(1); _Pragma("unroll") for (int m = 0; m < 4; ++m) _Pragma("unroll") for (int n = 0; n < 2; ++n) _Pragma("unroll") for (int k = 0; k < 2; ++k) \
        acc[ai][bj][m][n] = __builtin_amdgcn_mfma_f32_16x16x32_bf16(Bt[n][k], At[m][k], acc[ai][bj][m][n], 0, 0, 0); __builtin_amdgcn_s_setprio(0); } while (0)
#define PG8_WAIT_V(n) asm volatile("s_waitcnt vmcnt(" #n ")" ::: "memory")
#define PG8_WAIT_L(n) asm volatile("s_waitcnt lgkmcnt(" #n ")" ::: "memory")
#define PG8_BAR __builtin_amdgcn_s_barrier()
#define PG8_SCHED __builtin_amdgcn_sched_barrier(0)
    Unit cur, nxt; int ui = 0;
    if (!S.next(0, cur)) return;
    f32x4 acc[2][2][4][2];
#pragma unroll
    for (int a = 0; a < 2; ++a)
#pragma unroll
        for (int b = 0; b < 2; ++b)
#pragma unroll
            for (int m = 0; m < 4; ++m)
#pragma unroll
                for (int n = 0; n < 2; ++n) acc[a][b][m][n] = (f32x4){0.f, 0.f, 0.f, 0.f};
    bf16x8 At[4][2], B0[2][2], B1[2][2];
    const char* cA = (const char*)g.A + (size_t)cur.pm * tstep; const char* cB = (const char*)g.Bt + (size_t)cur.pn * tstep;
    typename Epi::State est = E.pre(cur, wr, fr, fq);
    if constexpr (SP2) {
        PG8_STAGE(PG8_SB(0, 0), cB, voffB); PG8_STAGE(PG8_SB(0, 1), cB + hstep, voffB); PG8_STAGE(PG8_SA(0, 0), cA, voffA); PG8_STAGE(PG8_SA(0, 1), cA + hstep, voffA);
        if (wr == 1) PG8_BAR;
        PG8_WAIT_V(2); PG8_BAR;
        PG8_STAGE(PG8_SB(1, 0), cB + kstep, voffB); PG8_STAGE(PG8_SA(1, 0), cA + kstep, voffA); PG8_STAGE(PG8_SB(1, 1), cB + hstep + kstep, voffB);
        PG8_WAIT_V(6); PG8_BAR;
    } else {
        PG8_STAGE(PG8_SB(0, 0), cB, voffB); PG8_STAGE(PG8_SA(0, 0), cA, voffA); PG8_STAGE(PG8_SB(0, 1), cB + hstep, voffB); PG8_STAGE(PG8_SA(0, 1), cA + hstep, voffA);
        if (wr == 1) PG8_BAR;
        PG8_WAIT_V(4); PG8_BAR;
        PG8_STAGE(PG8_SB(1, 0), cB + kstep, voffB); PG8_STAGE(PG8_SA(1, 0), cA + kstep, voffA); PG8_STAGE(PG8_SB(1, 1), cB + hstep + kstep, voffB);
        PG8_WAIT_V(6); PG8_BAR;
    }
    for (;;) {
        const bool has_next = S.next(ui + 1, nxt);
        const char* nA = has_next ? (const char*)g.A + (size_t)nxt.pm * tstep : cA; const char* nB = has_next ? (const char*)g.Bt + (size_t)nxt.pn * tstep : cB;
        for (int t = 0; t < nt; t += 2) {
            const bool last = (t == nt - 2);
            const char* a1 = cA + (size_t)(t + 1) * kstep;
            const char* a2 = last ? nA : cA + (size_t)(t + 2) * kstep; const char* b2 = last ? nB : cB + (size_t)(t + 2) * kstep;
            const char* a3 = a2 + kstep; const char* b3 = b2 + kstep;
            if constexpr (SP2) {
            PG8_LDB(B0, 0, 0); PG8_LDB(B1, 0, 1); PG8_SCHED; PG8_LDA(At, 0, 0); PG8_STAGE(PG8_SA(1, 1), a1 + hstep, voffA);
            PG8_WAIT_V(8); PG8_WAIT_L(0); PG8_BAR; PG8_MMA(0, 0, At, B0); PG8_MMA(0, 1, At, B1); PG8_BAR; PG8_SCHED;
            PG8_LDA(At, 0, 1); PG8_STAGE(PG8_SB(0, 0), b2, voffB); PG8_STAGE(PG8_SB(0, 1), b2 + hstep, voffB); PG8_STAGE(PG8_SA(0, 0), a2, voffA);
            PG8_WAIT_V(8); PG8_WAIT_L(0); PG8_BAR; PG8_MMA(1, 0, At, B0); PG8_MMA(1, 1, At, B1); PG8_BAR; PG8_SCHED;
            PG8_LDB(B0, 1, 0); PG8_LDB(B1, 1, 1); PG8_SCHED; PG8_LDA(At, 1, 0); PG8_STAGE(PG8_SA(0, 1), a2 + hstep, voffA);
            PG8_WAIT_V(8); PG8_WAIT_L(0); PG8_BAR; PG8_MMA(0, 0, At, B0); PG8_MMA(0, 1, At, B1); PG8_BAR; PG8_SCHED;
            PG8_LDA(At, 1, 1); PG8_STAGE(PG8_SB(1, 0), b3, voffB); PG8_STAGE(PG8_SB(1, 1), b3 + hstep, voffB); PG8_STAGE(PG8_SA(1, 0), a3, voffA);
            PG8_WAIT_V(8); PG8_WAIT_L(0); PG8_BAR; PG8_MMA(1, 0, At, B0); PG8_MMA(1, 1, At, B1); PG8_BAR; PG8_SCHED;
            } else {
            PG8_LDB(B0, 0, 0); PG8_SCHED; PG8_LDA(At, 0, 0); PG8_STAGE(PG8_SA(1, 1), a1 + hstep, voffA);
            PG8_WAIT_L(8); PG8_BAR; PG8_WAIT_L(0); PG8_MMA(0, 0, At, B0); PG8_BAR; PG8_SCHED;
            PG8_LDB(B1, 0, 1); PG8_STAGE(PG8_SB(0, 0), b2, voffB);
            PG8_BAR; PG8_WAIT_L(0); PG8_MMA(0, 1, At, B1); PG8_BAR;
            PG8_LDA(At, 0, 1); PG8_STAGE(PG8_SA(0, 0), a2, voffA);
            PG8_BAR; PG8_WAIT_L(0); PG8_MMA(1, 0, At, B0); PG8_BAR; PG8_SCHED;
            PG8_STAGE(PG8_SB(0, 1), b2 + hstep, voffB);
            PG8_WAIT_V(6); PG8_BAR; PG8_MMA(1, 1, At, B1); PG8_BAR;
            PG8_LDB(B0, 1, 0); PG8_SCHED; PG8_LDA(At, 1, 0); PG8_STAGE(PG8_SA(0, 1), a2 + hstep, voffA);
            PG8_WAIT_L(8); PG8_BAR; PG8_WAIT_L(0); PG8_MMA(0, 0, At, B0); PG8_BAR; PG8_SCHED;
            PG8_LDB(B1, 1, 1); PG8_STAGE(PG8_SB(1, 0), b3, voffB);
            PG8_BAR; PG8_WAIT_L(0); PG8_MMA(0, 1, At, B1); PG8_BAR;
            PG8_LDA(At, 1, 1); PG8_STAGE(PG8_SA(1, 0), a3, voffA);
            PG8_BAR; PG8_WAIT_L(0); PG8_MMA(1, 0, At, B0); PG8_BAR; PG8_SCHED;
            PG8_STAGE(PG8_SB(1, 1), b3 + hstep, voffB);
            PG8_WAIT_V(6); PG8_BAR; PG8_MMA(1, 1, At, B1); PG8_BAR;
            }
        }
        if constexpr (ALIGN_EPI) { if (wr == 0) PG8_BAR; }
        E(acc, cur, wr, wc, fr, fq, est);
        if (!has_next) break;
#pragma unroll
        for (int a = 0; a < 2; ++a)
#pragma unroll
            for (int b = 0; b < 2; ++b)
#pragma unroll
                for (int m = 0; m < 4; ++m)
#pragma unroll
                    for (int n = 0; n < 2; ++n) acc[a][b][m][n] = (f32x4){0.f, 0.f, 0.f, 0.f};
        cur = nxt; cA = nA; cB = nB; ++ui;
        est = E.pre(cur, wr, fr, fq);
        if constexpr (ALIGN_EPI) { if (wr == 1) PG8_BAR; }
    }
    PG8_WAIT_V(0);
    if constexpr (!ALIGN_EPI) { if (wr == 0) PG8_BAR; }
    PG8_BAR;
#undef PG8_SA
#undef PG8_SB
#undef PG8_STAGE
#undef PG8_LDA
#undef PG8_LDB
#undef PG8_MMA
#undef PG8_WAIT_V
#undef PG8_WAIT_L
#undef PG8_BAR
#undef PG8_SCHED
}

struct EpiStoreBf16 {
    static constexpr bool PERM = true;
    struct State { float ss[2][4]; };
    bf16_t* O; int ldc; const float* SS;
    __device__ __forceinline__ State pre(const Unit& u, int wr, int fr, int fq) const { State st;
#pragma unroll
        for (int ai = 0; ai < 2; ++ai)
#pragma unroll
            for (int m = 0; m < 4; ++m) st.ss[ai][m] = SS[u.pm * BM + ai * HALF + wr * 64 + m * 16 + fr];
        return st; }
    __device__ __forceinline__ void operator()(const f32x4 (&acc)[2][2][4][2], const Unit& u, int wr, int wc, int fr, int fq, const State& st) const {
        const int row0 = u.pm * BM + wr * 64 + fr, col0 = u.pn * BM + wc * 32 + 8 * fq;
#pragma unroll
        for (int ai = 0; ai < 2; ++ai)
#pragma unroll
            for (int m = 0; m < 4; ++m) { bf16_t* rowp = O + (size_t)(row0 + ai * HALF + m * 16) * ldc + col0;
                const float rs = rsqrtf(st.ss[ai][m] * (1.0f / DM) + EPS);
#pragma unroll
                for (int bj = 0; bj < 2; ++bj) { const f32x4 v0 = acc[ai][bj][m][0] * rs, v1 = acc[ai][bj][m][1] * rs;
                    u32x4 w; w.x = cvt_pk_bf16(v0[0], v0[1]); w.y = cvt_pk_bf16(v0[2], v0[3]); w.z = cvt_pk_bf16(v1[0], v1[1]); w.w = cvt_pk_bf16(v1[2], v1[3]);
                    *(u32x4*)(rowp + bj * HALF) = w; } }
    }
};

struct EpiResid {
    static constexpr bool PERM = true;
    struct State {}; __device__ __forceinline__ State pre(const Unit&, int, int, int) const { return State{}; }
    const bf16_t* XB; bf16_t* XN; float* RS;
    __device__ __forceinline__ void operator()(const f32x4 (&acc)[2][2][4][2], const Unit& u, int wr, int wc, int fr, int fq, const State&) const {
        const int row0 = u.pm * BM + wr * 64 + fr, col0 = u.pn * BM + wc * 32 + 8 * fq;
#pragma unroll
        for (int ai = 0; ai < 2; ++ai)
#pragma unroll
            for (int m = 0; m < 4; ++m) { const int row = row0 + ai * HALF + m * 16; const size_t ro = (size_t)row * DM + col0; float ss = 0.f;
#pragma unroll
                for (int bj = 0; bj < 2; ++bj) {
                    const u32x4 xw = *(const u32x4*)(XB + ro + bj * HALF);
                    const f32x4 x0 = (f32x4){bf_lo(xw.x), bf_hi(xw.x), bf_lo(xw.y), bf_hi(xw.y)}, x1 = (f32x4){bf_lo(xw.z), bf_hi(xw.z), bf_lo(xw.w), bf_hi(xw.w)};
                    const f32x4 v0 = acc[ai][bj][m][0] + x0, v1 = acc[ai][bj][m][1] + x1;
                    ss += (v0[0] * v0[0] + v0[1] * v0[1]) + (v0[2] * v0[2] + v0[3] * v0[3]) + (v1[0] * v1[0] + v1[1] * v1[1]) + (v1[2] * v1[2] + v1[3] * v1[3]);
                    u32x4 w; w.x = cvt_pk_bf16(v0[0], v0[1]); w.y = cvt_pk_bf16(v0[2], v0[3]); w.z = cvt_pk_bf16(v1[0], v1[1]); w.w = cvt_pk_bf16(v1[2], v1[3]);
                    *(u32x4*)(XN + ro + bj * HALF) = w; }
                ss += __shfl_xor(ss, 16); ss += __shfl_xor(ss, 32);
                if (fq == 0) atomicAdd(RS + row, ss); }
    }
};

struct EpiDown {
    static constexpr bool PERM = true;
    struct State {}; __device__ __forceinline__ State pre(const Unit&, int, int, int) const { return State{}; }
    const bf16_t* X1; float* OUT;
    __device__ __forceinline__ void operator()(const f32x4 (&acc)[2][2][4][2], const Unit& u, int wr, int wc, int fr, int fq, const State&) const {
        const int row0 = u.pm * BM + wr * 64 + fr, col0 = u.pn * BM + wc * 32 + 8 * fq;
#pragma unroll
        for (int ai = 0; ai < 2; ++ai)
#pragma unroll
            for (int m = 0; m < 4; ++m) { const size_t ro = (size_t)(row0 + ai * HALF + m * 16) * DM + col0;
#pragma unroll
                for (int bj = 0; bj < 2; ++bj) {
                    const u32x4 xw = *(const u32x4*)(X1 + ro + bj * HALF);
                    const f32x4 x0 = (f32x4){bf_lo(xw.x), bf_hi(xw.x), bf_lo(xw.y), bf_hi(xw.y)}, x1 = (f32x4){bf_lo(xw.z), bf_hi(xw.z), bf_lo(xw.w), bf_hi(xw.w)};
                    __builtin_nontemporal_store(acc[ai][bj][m][0] + x0, (f32x4*)(OUT + ro + bj * HALF)); __builtin_nontemporal_store(acc[ai][bj][m][1] + x1, (f32x4*)(OUT + ro + bj * HALF + 4)); } }
    }
};

struct EpiConvAct {
    static constexpr bool PERM = true;
    struct State { float rs[4]; };
    __device__ __forceinline__ State pre(const Unit& u, int wr, int fr, int fq) const { State st;
#pragma unroll
        for (int m = 0; m < 4; ++m) st.rs[m] = RS[u.pm * BM + (fq & 1) * HALF + wr * 64 + m * 16 + fr];
        return st; }
    const float* RS; const float* CW; const float* CB; bf16_t* ACT; float* HT; float* HB; LAS unsigned char* xlds;
    __device__ __forceinline__ static int xidx(int ai, int wr, int wc, int rsel, int bj, int n, int fq) { return ((((((ai * 2 + wr) * 4 + wc) * 2 + rsel) * 2 + bj) * 2 + n) * 4 + fq); }
    __device__ __forceinline__ void operator()(const f32x4 (&acc)[2][2][4][2], const Unit& u, int wr, int wc, int fr, int fq, const State& st) const {
        asm volatile("" : "+v"(fr), "+v"(fq));
        LAS f32x4* X = (LAS f32x4*)xlds;
        LAS float* RSL = (LAS float*)(xlds + 8192) + (wr * 4 + wc) * 128;
        if (fq < 2) {
#pragma unroll
            for (int m = 0; m < 4; ++m) RSL[(fq * 4 + m) * 16 + fr] = rsqrtf(st.rs[m] * (1.0f / DM) + EPS);
        }
        asm volatile("s_waitcnt lgkmcnt(0)" ::: "memory");
        if (fr >= 14) {
#pragma unroll
            for (int ai = 0; ai < 2; ++ai) { const float r3 = RSL[(ai * 4 + 3) * 16 + fr];
#pragma unroll
                for (int bj = 0; bj < 2; ++bj)
#pragma unroll
                    for (int n = 0; n < 2; ++n) X[xidx(ai, wr, wc, fr - 14, bj, n, fq)] = acc[ai][bj][3][n] * r3; }
        }
        __syncthreads();
        const int cbase = u.pn * HALF + wc * 32 + 8 * fq;
        f32x2 W0[2][4], W1[2][4], W2[2][4], BB[2][4];
#pragma unroll
        for (int n = 0; n < 2; ++n) {
            const int c = cbase + 4 * n;
            const f32x4 wg0 = *(const f32x4*)(CW + c), wg1 = *(const f32x4*)(CW + NUP + c), wg2 = *(const f32x4*)(CW + 2 * NUP + c), bg = *(const f32x4*)(CB + c);
            const f32x4 wu0 = *(const f32x4*)(CW + DFF + c), wu1 = *(const f32x4*)(CW + NUP + DFF + c), wu2 = *(const f32x4*)(CW + 2 * NUP + DFF + c), bu = *(const f32x4*)(CB + DFF + c);
#pragma unroll
            for (int e = 0; e < 4; ++e) { W0[n][e] = (f32x2){wg0[e], wu0[e]}; W1[n][e] = (f32x2){wg1[e], wu1[e]}; W2[n][e] = (f32x2){wg2[e], wu2[e]}; BB[n][e] = (f32x2){bg[e], bu[e]}; }
        }
#pragma unroll
        for (int ai = 0; ai < 2; ++ai) {
            f32x2 pp[2][4];
#pragma unroll
            for (int n = 0; n < 2; ++n)
#pragma unroll
                for (int e = 0; e < 4; ++e) pp[n][e] = (f32x2){0.f, 0.f};
            if (wr == 1 || ai == 1) {
                const int sa = (wr == 1) ? ai : 0, sw = (wr == 1) ? 0 : 1;
                if (fr >= 14) {
#pragma unroll
                    for (int n = 0; n < 2; ++n) { const f32x4 tg = X[xidx(sa, sw, wc, fr - 14, 0, n, fq)], tu = X[xidx(sa, sw, wc, fr - 14, 1, n, fq)];
#pragma unroll
                        for (int e = 0; e < 4; ++e) pp[n][e] = (f32x2){tg[e], tu[e]}; }
                }
            }
#pragma unroll
            for (int m = 0; m < 4; ++m) {
                const float rsv = RSL[(ai * 4 + m) * 16 + fr];
                const int row = u.pm * BM + ai * HALF + wr * 64 + m * 16 + fr;
                const bool edge0 = (ai == 0 && wr == 0 && m == 0 && fr < 2);
                const bool edge1 = (ai == 1 && wr == 1 && m == 3 && fr >= 14);
                u32x4 wv;
#pragma unroll
                for (int n = 0; n < 2; ++n) {
                    const f32x4 ag = acc[ai][0][m][n], au = acc[ai][1][m][n];
                    f32x2 cur[4]; f32x4 o;
#pragma unroll
                    for (int e = 0; e < 4; ++e) {
                        cur[e] = (f32x2){ag[e], au[e]} * rsv;
                        f32x2 p1, p2;
                        p1.x = dpp_f<0x111>(dpp_f<0x121>(0.f, pp[n][e].x), cur[e].x); p1.y = dpp_f<0x111>(dpp_f<0x121>(0.f, pp[n][e].y), cur[e].y);
                        p2.x = dpp_f<0x112>(dpp_f<0x122>(0.f, pp[n][e].x), cur[e].x); p2.y = dpp_f<0x112>(dpp_f<0x122>(0.f, pp[n][e].y), cur[e].y);
                        const f32x2 v = BB[n][e] + W0[n][e] * p2 + W1[n][e] * p1 + W2[n][e] * cur[e];
                        o[e] = gelu_tanh(v.x) * v.y;
                    }
                    if (n == 0) { wv.x = cvt_pk_bf16(o[0], o[1]); wv.y = cvt_pk_bf16(o[2], o[3]); } else { wv.z = cvt_pk_bf16(o[0], o[1]); wv.w = cvt_pk_bf16(o[2], o[3]); }
                    if (edge0) {
                        *(f32x4*)(HT + ((size_t)(u.pm * 2 + fr) * 2 + 0) * DFF + cbase + 4 * n) = (f32x4){cur[0].x, cur[1].x, cur[2].x, cur[3].x};
                        *(f32x4*)(HT + ((size_t)(u.pm * 2 + fr) * 2 + 1) * DFF + cbase + 4 * n) = (f32x4){cur[0].y, cur[1].y, cur[2].y, cur[3].y}; }
                    if (edge1) {
                        *(f32x4*)(HB + ((size_t)(u.pm * 2 + fr - 14) * 2 + 0) * DFF + cbase + 4 * n) = (f32x4){cur[0].x, cur[1].x, cur[2].x, cur[3].x};
                        *(f32x4*)(HB + ((size_t)(u.pm * 2 + fr - 14) * 2 + 1) * DFF + cbase + 4 * n) = (f32x4){cur[0].y, cur[1].y, cur[2].y, cur[3].y}; }
#pragma unroll
                    for (int e = 0; e < 4; ++e) pp[n][e] = cur[e];
                }
                if (!edge0) *(u32x4*)(ACT + (size_t)row * DFF + cbase) = wv;
                __builtin_amdgcn_sched_barrier(0);
            }
        }
    }
};
}

#define XB_TMO      128
#define XB_XCNT(j)  (256  + 64 * (j))
#define XB_XSUB(j)  (1280 + 64 * (j))
#define XB_XGEN(j)  (2304 + 64 * (j))
#define XB_TOP      3328
#define XB_TOPGEN   3392
#define XCD_BAR_WORDS 3456
#define XB_SPIN_CAP (1u << 18)
__device__ __forceinline__ unsigned xb_ld(unsigned* p)              { return __hip_atomic_load(p, __ATOMIC_RELAXED, __HIP_MEMORY_SCOPE_AGENT); }
__device__ __forceinline__ unsigned xb_add(unsigned* p, unsigned v) { return __hip_atomic_fetch_add(p, v, __ATOMIC_RELAXED, __HIP_MEMORY_SCOPE_AGENT); }
__device__ __forceinline__ unsigned xb_xcc_id() { return (unsigned)__builtin_amdgcn_s_getreg((3 << 11) | 20) & 0xFu; }
#define XB_SPIN(cond, bar) do { unsigned _sp = 0; while (cond) { __builtin_amdgcn_s_sleep(1); \
    if ((++_sp & 255u) == 0u) { if (xb_ld(&(bar)[XB_TMO])) break; if (_sp > XB_SPIN_CAP) { atomicAdd(&(bar)[XB_TMO], 1u); break; } } } } while (0)
struct XcdBarrier { unsigned* bar; unsigned x; volatile LAS unsigned* st; };
__device__ __forceinline__ XcdBarrier xcd_barrier_post(unsigned* bar, volatile LAS unsigned* st) {
    XcdBarrier b; b.bar = bar; b.x = xb_xcc_id(); b.st = st;
    if (threadIdx.x == 0) (void)xb_add(&bar[XB_XCNT(b.x)], 1u);
    return b;
}
__device__ __forceinline__ void xcd_barrier_complete(unsigned* bar, unsigned x, unsigned& nloc, unsigned& nx) {
    const unsigned G = gridDim.x * gridDim.y * gridDim.z;
    unsigned sum, cnt, mine, sp = 0u;
    for (;;) {
        sum = 0u; cnt = 0u; mine = 0u;
#pragma unroll
        for (unsigned j = 0; j < 16; ++j) { const unsigned c = xb_ld(&bar[XB_XCNT(j)]); sum += c; cnt += (c > 0u) ? 1u : 0u; mine = (j == x) ? c : mine; }
        if (sum == G) break;
        __builtin_amdgcn_s_sleep(1);
        if ((++sp & 255u) == 0u) { if (xb_ld(&bar[XB_TMO])) break; if (sp > XB_SPIN_CAP) { atomicAdd(&bar[XB_TMO], 1u); break; } }
    }
    nloc = mine > 0u ? mine : 1u; nx = cnt > 0u ? cnt : 1u;
}
__device__ __forceinline__ void xcd_barrier(const XcdBarrier& b) {
    asm volatile("s_waitcnt vmcnt(0)" ::: "memory");
    __syncthreads();
    if (threadIdx.x == 0) {
        unsigned* bar = b.bar;
        __builtin_amdgcn_s_waitcnt(0);
        unsigned nloc = b.st[0], nx = b.st[1];
        if (nloc == 0u) { xcd_barrier_complete(bar, b.x, nloc, nx); b.st[0] = nloc; b.st[1] = nx; }
        const unsigned old = xb_add(&bar[XB_XSUB(b.x)], 1u);
        const unsigned gen = old / nloc;
        if (old + 1u == (gen + 1u) * nloc) {
            __builtin_amdgcn_fence(__ATOMIC_RELEASE, "agent");
            asm volatile("s_waitcnt vmcnt(0)" ::: "memory");
            const unsigned og = xb_add(&bar[XB_TOP], 1u);
            const unsigned tg = og / nx;
            if (og + 1u == (tg + 1u) * nx) xb_add(&bar[XB_TOPGEN], 1u);
            else XB_SPIN(xb_ld(&bar[XB_TOPGEN]) == tg, bar);
            __builtin_amdgcn_fence(__ATOMIC_ACQUIRE, "agent");
            xb_add(&bar[XB_XGEN(b.x)], 1u);
            asm volatile("s_waitcnt vmcnt(0)" ::: "memory");
        } else {
            XB_SPIN(xb_ld(&bar[XB_XGEN(b.x)]) == gen, bar);
            __builtin_amdgcn_fence(__ATOMIC_ACQUIRE, "agent");
            asm volatile("s_waitcnt vmcnt(0)" ::: "memory");
        }
    }
    __syncthreads();
}

struct Args {
    const float* x; const int* pos; const float* g_mix; const float* w_in; const float* qg; const float* kg; const float* rcw; const float* rcb;
    const float* w_rg; const float* b_rg; const float* w_ig; const float* b_ig; const float* lam; const float* g_att; const float* g_rec; const float* w_out;
    const float* g_ffn; const float* w_up; const float* fcw; const float* fcb; const float* w_down;
    float* out; unsigned char* ws;
};

__device__ __forceinline__ void transpose_item(const float* W, int K, int N, bf16_t* WT, LAS float* scr, int item, int lane, const float* kscale, bool permup) {
    const int nblk = N / 32, kb = item / nblk, nb = item % nblk, k0 = 64 * kb, n0 = 32 * nb;
    float tv[32];
#pragma unroll
    for (int i = 0; i < 32; ++i) { const int kk = 2 * i + (lane >> 5); tv[i] = __builtin_nontemporal_load(W + (size_t)(k0 + kk) * N + n0 + (lane & 31)); }
#pragma unroll
    for (int i = 0; i < 32; ++i) { const int kk = 2 * i + (lane >> 5); float v = tv[i]; if (kscale) v *= kscale[k0 + kk]; scr[kk * 33 + (lane & 31)] = v; }
    asm volatile("s_waitcnt lgkmcnt(0)" ::: "memory");
    const int c = lane & 7;
#pragma unroll
    for (int j = 0; j < 4; ++j) { const int n = (lane >> 3) + 8 * j; const LAS float* s = scr + (8 * c) * 33 + n;
        u32x4 o; o.x = pk2(s[0 * 33], s[1 * 33]); o.y = pk2(s[2 * 33], s[3 * 33]); o.z = pk2(s[4 * 33], s[5 * 33]); o.w = pk2(s[6 * 33], s[7 * 33]);
        int nn = n0 + n; if (permup) { const int bjs = nn / DFF, rem = nn % DFF; nn = (rem / 128) * 256 + bjs * 128 + (rem % 128); }
        *(u32x4*)(WT + (size_t)nn * K + k0 + 8 * c) = o; }
    asm volatile("s_waitcnt lgkmcnt(0)" ::: "memory");
}

constexpr int XCS = 68;
template <bool FINAL>
__device__ __forceinline__ void lru_chunk(const Args& a, LAS unsigned char* lds, int item, int tid) {
    const int lane = tid & 63, w = __builtin_amdgcn_readfirstlane(tid >> 6), fr = lane & 15, fq = lane >> 4;
    const int b = item >> 6, c = item & 63, tok0 = b * SEQ + c * 64;
    const bf16_t* PROJ = (const bf16_t*)(a.ws + WS_PROJ);
    float* CHA = (float*)(a.ws + WS_CHS); float* CHH = CHA + 4 * 64 * 512;
    LAS float* XC = (LAS float*)lds + w * (64 * XCS);
    const float* CINB = (const float*)(a.ws + WS_HT);
    LAS float* HL = (LAS float*)(lds + 8 * 64 * XCS * 4 + 2048) + w * 192;
    {
        const int rsub = lane >> 3, c8 = lane & 7;
        const bf16_t* px = PROJ + (size_t)tok0 * NIN + 1536 + 64 * w + 8 * c8;
        u32x4 rv[9];
#pragma unroll
        for (int i = 0; i < 9; ++i) { const int row = 8 * i - 8 + rsub; rv[i] = (u32x4){0u, 0u, 0u, 0u};
            if (row >= 0 || (c > 0 && row >= -3)) rv[i] = *(const u32x4*)(px + (long)row * NIN); }
#pragma unroll
        for (int i = 0; i < 9; ++i) { const int row = 8 * i - 8 + rsub;
            const f32x4 lo = (f32x4){bf_lo(rv[i].x), bf_hi(rv[i].x), bf_lo(rv[i].y), bf_hi(rv[i].y)}, hi = (f32x4){bf_lo(rv[i].z), bf_hi(rv[i].z), bf_lo(rv[i].w), bf_hi(rv[i].w)};
            if (row >= 0) { *(LAS f32x4*)(XC + row * XCS + 8 * c8) = lo; *(LAS f32x4*)(XC + row * XCS + 8 * c8 + 4) = hi; }
            else if (row >= -3) { *(LAS f32x4*)(HL + (row + 3) * 64 + 8 * c8) = lo; *(LAS f32x4*)(HL + (row + 3) * 64 + 8 * c8 + 4) = hi; } }
    }
    asm volatile("s_waitcnt lgkmcnt(0)" ::: "memory");
    {
        const int cgl = 64 * w + lane;
        const float w0 = a.rcw[cgl], w1 = a.rcw[512 + cgl], w2 = a.rcw[1024 + cgl], w3 = a.rcw[1536 + cgl], cb = a.rcb[cgl];
        float x3 = HL[lane], x2 = HL[64 + lane], x1 = HL[128 + lane];
#pragma unroll 8
        for (int tt = 0; tt < 64; ++tt) {
            const float x0 = XC[tt * XCS + lane];
            XC[tt * XCS + lane] = cb + w0 * x3 + w1 * x2 + w2 * x1 + w3 * x0;
            x3 = x2; x2 = x1; x1 = x0;
        }
    }
    __syncthreads();
    bf16x8 af[4][2];
#pragma unroll
    for (int mt = 0; mt < 4; ++mt)
#pragma unroll
        for (int kk = 0; kk < 2; ++kk) {
            const LAS float* p = XC + (16 * mt + fr) * XCS + 32 * kk + 8 * fq;
            const f32x4 v0 = *(const LAS f32x4*)p, v1 = *(const LAS f32x4*)(p + 4);
            u32x4 pk; pk.x = pk2(v0[0], v0[1]); pk.y = pk2(v0[2], v0[3]); pk.z = pk2(v1[0], v1[1]); pk.w = pk2(v1[2], v1[3]);
            af[mt][kk] = __builtin_bit_cast(bf16x8, pk);
        }
    const bf16_t* WGT = (const bf16_t*)(a.ws + WS_WG);
    bf16x8 nbr[2], nbi[2]; float nbrg, nbig, nlam, ncin = 0.f;
    { const int chl = fr, cgl = 64 * w + chl;
#pragma unroll
        for (int kk = 0; kk < 2; ++kk) { nbr[kk] = *(const bf16x8*)(WGT + ((size_t)(w * 64 + chl) * 64 + 32 * kk + 8 * fq)); nbi[kk] = *(const bf16x8*)(WGT + 32768 + ((size_t)(w * 64 + chl) * 64 + 32 * kk + 8 * fq)); }
        nbrg = a.b_rg[cgl]; nbig = a.b_ig[cgl]; nlam = a.lam[cgl]; if (FINAL) ncin = CINB[(size_t)item * 512 + cgl]; }
#pragma unroll 1
    for (int nt = 0; nt < 4; ++nt) {
        const int chl = 16 * nt + fr, cgl = 64 * w + chl;
        const bf16x8 br0 = nbr[0], br1 = nbr[1], bi0 = nbi[0], bi1 = nbi[1];
        const float brgl = -LOG2E * nbrg, bigl = -LOG2E * nbig, cin0 = ncin;
        const float sp8 = -8.0f * log1pf(expf(-nlam));
        const float sp8l = sp8 * LOG2E, sp82 = 2.f * sp8;
        if (nt < 3) { const int chn = chl + 16, cgn = cgl + 16;
#pragma unroll
            for (int kk = 0; kk < 2; ++kk) { nbr[kk] = *(const bf16x8*)(WGT + ((size_t)(w * 64 + chn) * 64 + 32 * kk + 8 * fq)); nbi[kk] = *(const bf16x8*)(WGT + 32768 + ((size_t)(w * 64 + chn) * 64 + 32 * kk + 8 * fq)); }
            nbrg = a.b_rg[cgn]; nbig = a.b_ig[cgn]; nlam = a.lam[cgn]; if (FINAL) ncin = CINB[(size_t)item * 512 + cgn]; }
        float carry = 0.f, cumP = 1.f;
        if (FINAL) carry = cin0;
#pragma unroll
        for (int mt = 0; mt < 4; ++mt) {
            f32x4 dr = (f32x4){0.f, 0.f, 0.f, 0.f}, di = dr;
            dr = __builtin_amdgcn_mfma_f32_16x16x32_bf16(af[mt][0], br0, dr, 0, 0, 0); dr = __builtin_amdgcn_mfma_f32_16x16x32_bf16(af[mt][1], br1, dr, 0, 0, 0);
            di = __builtin_amdgcn_mfma_f32_16x16x32_bf16(af[mt][0], bi0, di, 0, 0, 0); di = __builtin_amdgcn_mfma_f32_16x16x32_bf16(af[mt][1], bi1, di, 0, 0, 0);
            float hl[4], pl[4];
#pragma unroll
            for (int j = 0; j < 4; ++j) {
                const float r = fast_rcp(1.f + fast_exp2(fmaf(dr[j], -LOG2E, brgl))), ig = fast_rcp(1.f + fast_exp2(fmaf(di[j], -LOG2E, bigl)));
                const float av = fast_exp2(sp8l * r), x2 = sp82 * r;
                const float ser = -x2 * (1.f + x2 * (0.5f + x2 * (0.16666667f + x2 * (0.041666668f + x2 * 0.0083333338f))));
                const float om = (x2 > -0.3f) ? ser : (1.f - av * av);
                const float mult = __builtin_amdgcn_sqrtf(om);
                const float xv = XC[(16 * mt + 4 * fq + j) * XCS + chl];
                const float uv = mult * ig * xv;
                if (j == 0) { hl[0] = uv; pl[0] = av; } else { hl[j] = av * hl[j - 1] + uv; pl[j] = av * pl[j - 1]; }
            }
            float IA = pl[3], IH = hl[3];
            { const float pa = __shfl_up(IA, 16), ph = __shfl_up(IH, 16); if (fq >= 1) { IH = IA * ph + IH; IA = IA * pa; } }
            { const float pa = __shfl_up(IA, 32), ph = __shfl_up(IH, 32); if (fq >= 2) { IH = IA * ph + IH; IA = IA * pa; } }
            float EA = __shfl_up(IA, 16), EH = __shfl_up(IH, 16); if (fq == 0) { EA = 1.f; EH = 0.f; }
            const float hs = EA * carry + EH, ps = EA * cumP;
            if (FINAL) {
#pragma unroll
                for (int j = 0; j < 4; ++j) XC[(16 * mt + 4 * fq + j) * XCS + chl] = pl[j] * hs + hl[j];
            }
            const float TA = __shfl(IA, 48 + fr), TH = __shfl(IH, 48 + fr);
            carry = TA * carry + TH; cumP = TA * cumP;
            (void)ps;
        }
        if (!FINAL && fq == 0) { CHA[(size_t)item * 512 + cgl] = cumP; CHH[(size_t)item * 512 + cgl] = carry; }
    }
}

constexpr int QS_B = 144, VT_B = 784;
constexpr int AQ_OFF = 0, AK_OFF = 256 * QS_B, AV_OFF = AK_OFF + 384 * QS_B;
static_assert(AV_OFF + 64 * VT_B <= MISC_OFF, "attention LDS map");
struct AttnItem { int g, b, h, c, n0; };
__device__ __forceinline__ AttnItem attn_item(int k, int G, int bid) {
    int bh, idx;
    if (G == 256) { const int x = bid & 7, j = bid >> 3, p = 32 * (k % 6) + j; bh = 4 * x + p / 48; idx = p % 48; }
    else { const int p = (bid + k * G) % 1536; bh = p / 48; idx = p % 48; }
    AttnItem it; it.g = idx >> 4; it.b = bh >> 3; it.h = bh & 7; const int cn = 2 * (idx & 15), nbk = 32 >> (2 * it.g); it.c = cn / nbk; it.n0 = cn % nbk; return it;
}
__device__ __forceinline__ void attn_load(const bf16_t* PROJ, const AttnItem it, int tid, u32x4 (&pq)[4], u32x4 (&pk)[6], u32x4 (&pv0)[3], u32x4 (&pv1)[3]) {
    const int ds = 2 * it.g, n0 = it.n0;
    const int qb = (it.b * SEQ + (128 * n0) * (1 << ds) + it.c) * NIN + it.h * 64;
    const int kb_ = (it.b * SEQ + (128 * (n0 - 1)) * (1 << ds) + it.c) * NIN + it.h * 64;
    const int rstep = NIN << ds;
#pragma unroll
    for (int i = 0; i < 4; ++i) { const int task = tid + 512 * i, row = task >> 3, ch = task & 7;
        pq[i] = *(const u32x4*)(PROJ + (qb + row * rstep + 8 * ch)); }
#pragma unroll
    for (int i = 0; i < 6; ++i) { const int task = tid + 512 * i, row = task >> 3, ch = task & 7;
        pk[i] = (u32x4){0u, 0u, 0u, 0u};
        if (n0 > 0 || row >= 128) pk[i] = *(const u32x4*)(PROJ + (kb_ + row * rstep + 512 + 8 * ch)); }
#pragma unroll
    for (int i = 0; i < 3; ++i) { const int kp = 8 * (3 * (tid >> 6) + i) + ((tid & 63) >> 3), dc = tid & 7, key = 2 * kp;
        pv0[i] = (u32x4){0u, 0u, 0u, 0u}; pv1[i] = pv0[i];
        if (n0 > 0 || key >= 128) { const int eo = kb_ + key * rstep + 1024 + 8 * dc; pv0[i] = *(const u32x4*)(PROJ + eo); pv1[i] = *(const u32x4*)(PROJ + (eo + rstep)); } }
}
__device__ __forceinline__ void attn_stage(LAS unsigned char* lds, int tid, const u32x4 (&pq)[4], const u32x4 (&pk)[6], const u32x4 (&pv0)[3], const u32x4 (&pv1)[3]) {
#pragma unroll
    for (int i = 0; i < 4; ++i) { const int task = tid + 512 * i, row = task >> 3, ch = task & 7; *(LAS u32x4*)(lds + AQ_OFF + row * QS_B + ch * 16) = pq[i]; }
#pragma unroll
    for (int i = 0; i < 6; ++i) { const int task = tid + 512 * i, row = task >> 3, ch = task & 7; *(LAS u32x4*)(lds + AK_OFF + row * QS_B + ch * 16) = pk[i]; }
#pragma unroll
    for (int i = 0; i < 3; ++i) { const int kp = 8 * (3 * (tid >> 6) + i) + ((tid & 63) >> 3), dc = tid & 7, key = 2 * kp;
        const u32x4 v0 = pv0[i], v1 = pv1[i];
        const int rr = key & 31, phys0 = (key & ~31) + 8 * ((rr & 15) >> 2) + 4 * (rr >> 4) + (rr & 3);
        const int phys = (((phys0 >> 3) ^ dc) << 3) | (phys0 & 7);
        LAS unsigned char* vb = lds + AV_OFF + (8 * dc) * VT_B + phys * 2;
        *(LAS unsigned*)(vb + 0 * VT_B) = (v0.x & 0xffffu) | (v1.x << 16); *(LAS unsigned*)(vb + 1 * VT_B) = (v0.x >> 16) | (v1.x & 0xffff0000u);
        *(LAS unsigned*)(vb + 2 * VT_B) = (v0.y & 0xffffu) | (v1.y << 16); *(LAS unsigned*)(vb + 3 * VT_B) = (v0.y >> 16) | (v1.y & 0xffff0000u);
        *(LAS unsigned*)(vb + 4 * VT_B) = (v0.z & 0xffffu) | (v1.z << 16); *(LAS unsigned*)(vb + 5 * VT_B) = (v0.z >> 16) | (v1.z & 0xffff0000u);
        *(LAS unsigned*)(vb + 6 * VT_B) = (v0.w & 0xffffu) | (v1.w << 16); *(LAS unsigned*)(vb + 7 * VT_B) = (v0.w >> 16) | (v1.w & 0xffff0000u); }
}
__device__ __forceinline__ void attn_phase(const Args& a, LAS unsigned char* lds, int G, int bid, int tid) {
    const int lane = tid & 63, w = __builtin_amdgcn_readfirstlane(tid >> 6), fr = lane & 15, fq = lane >> 4;
    const bf16_t* PROJ = (const bf16_t*)(a.ws + WS_PROJ);
    bf16_t* OB = (bf16_t*)(a.ws + WS_OB); float* LS = (float*)(a.ws + WS_LSUM);
    const float M2 = 8.0f * LOG2E * wave_max(fabsf(a.qg[lane])) * wave_max(fabsf(a.kg[lane]));
    const int nk = ((G == 256) ? 6 : (1536 - bid + G - 1) / G) * REPI_P2;
    u32x4 pq[4], pk[6], pv0[3], pv1[3];
    AttnItem cur = attn_item(0, G, bid);
    if (nk > 0) attn_load(PROJ, cur, tid, pq, pk, pv0, pv1);
    for (int k = 0; k < nk; ++k) {
        const int g = cur.g, h = cur.h, c = cur.c, n0 = cur.n0, ds = 2 * g;
        const size_t tokb = (size_t)cur.b * SEQ;
        __syncthreads();
        attn_stage(lds, tid, pq, pk, pv0, pv1);
        __syncthreads();
        if (k + 1 < nk) { cur = attn_item(k + 1, G, bid); attn_load(PROJ, cur, tid, pq, pk, pv0, pv1); }
        const int tb = w >> 2, q0 = 32 * (w & 3);
        bf16x8 qf[2][2];
#pragma unroll
        for (int qt = 0; qt < 2; ++qt)
#pragma unroll
            for (int kk = 0; kk < 2; ++kk) qf[qt][kk] = *(const LAS bf16x8*)(lds + AQ_OFF + (128 * tb + q0 + 16 * qt + fr) * QS_B + (32 * kk + 8 * fq) * 2);
        f32x4 o[2][4];
#pragma unroll
        for (int qt = 0; qt < 2; ++qt)
#pragma unroll
            for (int dt = 0; dt < 4; ++dt) o[qt][dt] = (f32x4){0.f, 0.f, 0.f, 0.f};
        float lsum[2] = {0.f, 0.f};
        const bool pad = (tb == 0 && n0 == 0);
#pragma unroll 1
        for (int blk = 0; blk < 5; ++blk) {
            const int kb = q0 + 32 * blk;
            if (pad && kb + 32 <= 128) continue;
            const int kw = 128 * tb + kb;
            bf16x8 kf[2][2], vf[4];
#pragma unroll
            for (int t = 0; t < 2; ++t)
#pragma unroll
                for (int kk = 0; kk < 2; ++kk) kf[t][kk] = *(const LAS bf16x8*)(lds + AK_OFF + (kw + 16 * t + fr) * QS_B + (32 * kk + 8 * fq) * 2);
#pragma unroll
            for (int dt = 0; dt < 4; ++dt) vf[dt] = *(const LAS bf16x8*)(lds + AV_OFF + (16 * dt + fr) * VT_B + ((((kw >> 3) + fq) ^ ((2 * dt + (fr >> 3)) & 7)) << 4));
            f32x4 s[2][2];
#pragma unroll
            for (int qt = 0; qt < 2; ++qt)
#pragma unroll
                for (int t = 0; t < 2; ++t) { s[qt][t] = (f32x4){-M2, -M2, -M2, -M2};
#pragma unroll
                    for (int kk = 0; kk < 2; ++kk) s[qt][t] = __builtin_amdgcn_mfma_f32_16x16x32_bf16(kf[t][kk], qf[qt][kk], s[qt][t], 0, 0, 0); }
            float p[2][2][4];
            if (blk >= 1 && blk <= 3) {
#pragma unroll
                for (int qt = 0; qt < 2; ++qt)
#pragma unroll
                    for (int t = 0; t < 2; ++t)
#pragma unroll
                        for (int j = 0; j < 4; ++j) { const float pv = fast_exp2(s[qt][t][j]); p[qt][t][j] = pv; lsum[qt] += pv; }
            } else {
#pragma unroll
                for (int qt = 0; qt < 2; ++qt) {
                    const int qi = q0 + 16 * qt + fr;
                    const int dlo = pad ? max(0, 128 - qi) : 0;
                    const int dbase = kb + 4 * fq - qi - dlo;
#pragma unroll
                    for (int t = 0; t < 2; ++t)
#pragma unroll
                        for (int j = 0; j < 4; ++j) { const bool valid = (unsigned)(dbase + 16 * t + j) <= (unsigned)(128 - dlo);
                            const float pv = valid ? fast_exp2(s[qt][t][j]) : 0.f; p[qt][t][j] = pv; lsum[qt] += pv; }
                }
            }
#pragma unroll
            for (int qt = 0; qt < 2; ++qt) {
                u32x4 pkd; pkd.x = pk2(p[qt][0][0], p[qt][0][1]); pkd.y = pk2(p[qt][0][2], p[qt][0][3]); pkd.z = pk2(p[qt][1][0], p[qt][1][1]); pkd.w = pk2(p[qt][1][2], p[qt][1][3]);
                const bf16x8 pb = __builtin_bit_cast(bf16x8, pkd);
#pragma unroll
                for (int dt = 0; dt < 4; ++dt) o[qt][dt] = __builtin_amdgcn_mfma_f32_16x16x32_bf16(vf[dt], pb, o[qt][dt], 0, 0, 0);
            }
        }
#pragma unroll
        for (int qt = 0; qt < 2; ++qt) {
            float ls = lsum[qt]; ls += __shfl_xor(ls, 16); ls += __shfl_xor(ls, 32);
            const float inv = 1.0f / ls;
            const size_t tq = tokb + (((size_t)(128 * (n0 + tb) + q0 + 16 * qt + fr)) << ds) + c;
            bf16_t* op = OB + ((size_t)g * MTOK + tq) * 512 + h * 64 + 4 * fq;
#pragma unroll
            for (int dt = 0; dt < 4; ++dt) { u32x2 wv; wv.x = pk2(o[qt][dt][0] * inv, o[qt][dt][1] * inv); wv.y = pk2(o[qt][dt][2] * inv, o[qt][dt][3] * inv); *(u32x2*)(op + 16 * dt) = wv; }
            if (fq == 0) LS[((size_t)g * MTOK + tq) * 8 + h] = ls;
        }
    }
}

__global__ void __launch_bounds__(512, 2) fwd_kernel(Args a) {
    extern __shared__ __attribute__((aligned(16))) unsigned char lds_raw[];
    LAS unsigned char* lds = (LAS unsigned char*)lds_raw;
    cg::grid_group grid = cg::this_grid();
    const int wave = __builtin_amdgcn_readfirstlane(threadIdx.x >> 6);
    const int G = gridDim.x, bid = blockIdx.x;
#define FRESH_TID() const int lane = fresh_lane(), tid = wave * 64 + lane; (void)tid; (void)lane
    const int gw = bid * 8 + wave, NGW = G * 8;
    unsigned char* ws = a.ws;
    bf16_t* WIN = (bf16_t*)(ws + WS_WIN); bf16_t* WOUT = (bf16_t*)(ws + WS_WOUT); bf16_t* WDN = (bf16_t*)(ws + WS_WDN); bf16_t* WUP = (bf16_t*)(ws + WS_WUP);
    bf16_t* XN = (bf16_t*)(ws + WS_XN); bf16_t* PROJ = (bf16_t*)(ws + WS_PROJ); bf16_t* MIX = (bf16_t*)(ws + WS_MIX); bf16_t* ACT = (bf16_t*)(ws + WS_ACT);
    bf16_t* OB = (bf16_t*)(ws + WS_OB); float* LS = (float*)(ws + WS_LSUM);
    unsigned* BARW = (unsigned*)(ws + WS_BAR); bf16_t* WGT = (bf16_t*)(ws + WS_WG);
    if (threadIdx.x < 2) ((volatile LAS unsigned*)(lds + MISC_OFF))[threadIdx.x] = 0u;
    __syncthreads();
    (void)xcd_barrier_post(BARW, (volatile LAS unsigned*)(lds + MISC_OFF));
#define GSYNC() do { XcdBarrier xb_; xb_.bar = (unsigned*)(a.ws + WS_BAR); xb_.x = xb_xcc_id(); xb_.st = (volatile LAS unsigned*)(lds + MISC_OFF); xcd_barrier(xb_); } while (0)
    float* RS = (float*)(ws + WS_RS); float* RS0 = (float*)(ws + WS_RS0); f32x2* CS = (f32x2*)(ws + WS_CS); float* HT = (float*)(ws + WS_HT); float* HB = (float*)(ws + WS_HB);

    for (int rep = 0; rep < REP_P0; ++rep) {
        if (rep) GSYNC();
        FRESH_TID();
        LAS float* scr = (LAS float*)(lds + wave * 16384);
        constexpr int I_IN = (DM / 64) * (NIN / 32);
        for (int it = gw; it < I_IN; it += NGW) transpose_item(a.w_in, DM, NIN, WIN, scr, it, lane, a.g_mix, false);
        {
            for (int m0 = gw * 4; m0 < MTOK; m0 += NGW * 4) {
                f32x4 v[4][4];
#pragma unroll
                for (int q = 0; q < 4; ++q) { const f32x4* xr = (const f32x4*)(a.x + (size_t)(m0 + q) * DM) + lane;
#pragma unroll
                    for (int j = 0; j < 4; ++j) v[q][j] = __builtin_nontemporal_load(xr + 64 * j); }
#pragma unroll
                for (int q = 0; q < 4; ++q) { float s = 0.f;
#pragma unroll
                    for (int j = 0; j < 4; ++j) s += (v[q][j][0] * v[q][j][0] + v[q][j][1] * v[q][j][1]) + (v[q][j][2] * v[q][j][2] + v[q][j][3] * v[q][j][3]);
                    const float ssum = wave_sum(s);
                    if (lane == 0) RS0[m0 + q] = ssum;
                    u32x2* o8 = (u32x2*)(XN + (size_t)(m0 + q) * DM) + lane;
#pragma unroll
                    for (int j = 0; j < 4; ++j) { u32x2 wv; wv.x = pk2(v[q][j][0], v[q][j][1]); wv.y = pk2(v[q][j][2], v[q][j][3]); o8[64 * j] = wv; } }
            }
        }
        for (int idx = bid * 512 + tid; idx < MTOK * 32; idx += G * 512) {
            const int tok = idx >> 5, i = idx & 31;
            const float invf = powf(10000.0f, -(float)i * (1.0f / 32.0f));
            const float ang = (float)a.pos[tok] * invf;
            const float kq = rintf(ang * 0.15915494309189535f);
            float rr = fmaf(-kq, 6.2831854820251465f, ang); rr = fmaf(-kq, -1.7484556000744883e-07f, rr);
            CS[idx] = (f32x2){__cosf(rr), __sinf(rr)};
        }
        for (int idx = bid * 512 + tid; idx < 2 * 8 * 64 * 64; idx += G * 512) {
            const int in = idx & 63, out = (idx >> 6) & 63, n = (idx >> 12) & 7, mat = idx >> 15;
            WGT[idx] = (bf16_t)f2bf((mat ? a.w_ig : a.w_rg)[(n * 64 + in) * 64 + out]);
        }
    }
    if (a.ws == nullptr) grid.sync();
    GSYNC();
#define GSYNC_UNUSED() do { XcdBarrier xb_; xb_.bar = (unsigned*)(a.ws + WS_BAR); xb_.x = xb_xcc_id(); xb_.st = (volatile LAS unsigned*)(lds + MISC_OFF); xcd_barrier(xb_); } while (0)
    for (int rep = 0; rep < REP_SYNC; ++rep) GSYNC();

    for (int rep = 0; rep < REP_P1; ++rep) {
        if (rep) GSYNC();
        pg8::Gemm g{XN, WIN, MTOK, NIN, DM}; pg8::StaticOrder S; S.init(MTOK, NIN, G, bid, REPG_P1);
        pg8::EpiStoreBf16 E{PROJ, NIN, RS0};
        pg8::gemm_phase<pg8::EpiStoreBf16, pg8::StaticOrder, true, true>(lds, g, S, E, wave);
        if (rep == 0) {
            FRESH_TID();
            constexpr int NU = (MTOK / 256) * (NIN / 256) * REPG_P1;
            const int rem = NU % G, first = rem, nwg = G - first;
            if (bid >= first) {
                LAS float* scr = (LAS float*)(lds + wave * 16384);
                constexpr int I_OUT = (DM / 64) * (DM / 32), I_UP = (DM / 64) * (NUP / 32), I_DN = (DFF / 64) * (DM / 32);
                for (int it = (bid - first) * 8 + wave; it < I_OUT + I_UP + I_DN; it += nwg * 8) {
                    int r = it;
                    if (r < I_OUT) { transpose_item(a.w_out, DM, DM, WOUT, scr, r, lane, nullptr, false); continue; } r -= I_OUT;
                    if (r < I_UP) { transpose_item(a.w_up, DM, NUP, WUP, scr, r, lane, a.g_ffn, true); continue; } r -= I_UP;
                    transpose_item(a.w_down, DFF, DM, WDN, scr, r, lane, nullptr, false);
                }
            }
        }
    }
    GSYNC();

    {
        FRESH_TID();
        for (int rep = 0; rep < REP_LRUA; ++rep) { if (rep) GSYNC();
        for (int item = bid; item < 256; item += G) { __syncthreads(); lru_chunk<false>(a, lds, item, tid); } }
        {
            const int d0 = 8 * (lane & 7);
            const bool hi = (lane & 4) != 0;
            float gq[8], gk[8];
#pragma unroll
            for (int j = 0; j < 8; ++j) { gq[j] = a.qg[d0 + j] * (0.125f * LOG2E); gk[j] = a.kg[d0 + j]; }
            for (int tok0 = gw * 4; tok0 < MTOK; tok0 += NGW * 4) {
                u32x4 rq[4], rk[4]; f32x4 csv[4][4];
#pragma unroll
                for (int q = 0; q < 4; ++q) { const bf16_t* pq = PROJ + (size_t)(tok0 + q) * NIN + 8 * lane; rq[q] = *(const u32x4*)pq; rk[q] = *(const u32x4*)(pq + 512);
                    const f32x4* cs4 = (const f32x4*)(CS + (size_t)(tok0 + q) * 32 + 8 * (lane & 3));
#pragma unroll
                    for (int j = 0; j < 4; ++j) csv[q][j] = __builtin_nontemporal_load(cs4 + j); }
#pragma unroll
                for (int q = 0; q < 4; ++q) {
                    float qv[8], kv[8];
                    qv[0] = bf_lo(rq[q].x); qv[1] = bf_hi(rq[q].x); qv[2] = bf_lo(rq[q].y); qv[3] = bf_hi(rq[q].y); qv[4] = bf_lo(rq[q].z); qv[5] = bf_hi(rq[q].z); qv[6] = bf_lo(rq[q].w); qv[7] = bf_hi(rq[q].w);
                    kv[0] = bf_lo(rk[q].x); kv[1] = bf_hi(rk[q].x); kv[2] = bf_lo(rk[q].y); kv[3] = bf_hi(rk[q].y); kv[4] = bf_lo(rk[q].z); kv[5] = bf_hi(rk[q].z); kv[6] = bf_lo(rk[q].w); kv[7] = bf_hi(rk[q].w);
                    float sq = 0.f, sk = 0.f;
#pragma unroll
                    for (int j = 0; j < 8; ++j) { sq += qv[j] * qv[j]; sk += kv[j] * kv[j]; }
                    sq += __shfl_xor(sq, 1); sq += __shfl_xor(sq, 2); sq += __shfl_xor(sq, 4);
                    sk += __shfl_xor(sk, 1); sk += __shfl_xor(sk, 2); sk += __shfl_xor(sk, 4);
                    const float rq_ = rsqrtf(sq * (1.f / 64.f) + EPS), rk_ = rsqrtf(sk * (1.f / 64.f) + EPS);
                    float oq[8], ok[8];
#pragma unroll
                    for (int j = 0; j < 8; ++j) {
                        const float qn = qv[j] * rq_ * gq[j], kn = kv[j] * rk_ * gk[j];
                        const float qp = __shfl_xor(qn, 4), kp = __shfl_xor(kn, 4);
                        const float cc = csv[q][j >> 1][2 * (j & 1)], sn = csv[q][j >> 1][2 * (j & 1) + 1];
                        oq[j] = hi ? (qn * cc + qp * sn) : (qn * cc - qp * sn);
                        ok[j] = hi ? (kn * cc + kp * sn) : (kn * cc - kp * sn);
                    }
                    u32x4 wq, wk; wq.x = pk2(oq[0], oq[1]); wq.y = pk2(oq[2], oq[3]); wq.z = pk2(oq[4], oq[5]); wq.w = pk2(oq[6], oq[7]);
                    wk.x = pk2(ok[0], ok[1]); wk.y = pk2(ok[2], ok[3]); wk.z = pk2(ok[4], ok[5]); wk.w = pk2(ok[6], ok[7]);
                    bf16_t* pq = PROJ + (size_t)(tok0 + q) * NIN + 8 * lane;
                    *(u32x4*)pq = wq; *(u32x4*)(pq + 512) = wk;
                }
            }
        }
    }
    GSYNC();

    {
        FRESH_TID();
        float* CINB = HT;
        const float* CHA = (const float*)(ws + WS_CHS); const float* CHH = CHA + 4 * 64 * 512;
        for (int p = gw; p < 4 * 512; p += NGW) {
            const int b = p >> 9, ch = p & 511; const size_t o = ((size_t)(b * 64 + lane)) * 512 + ch;
            float IA = CHA[o], IH = CHH[o];
#pragma unroll
            for (int off = 1; off < 64; off <<= 1) { const float pa = __shfl_up(IA, off), ph = __shfl_up(IH, off); if (lane >= off) { IH = IA * ph + IH; IA = IA * pa; } }
            float EH = __shfl_up(IH, 1); if (lane == 0) EH = 0.f;
            CINB[o] = EH;
        }
    }
    for (int rep = 0; rep < REP_P2; ++rep) { FRESH_TID(); attn_phase(a, lds, G, bid, tid); GSYNC(); }

    for (int rep = 0; rep < REP_P3; ++rep) { if (rep) GSYNC();
    FRESH_TID();
    for (int item = bid; item < 256; item += G) {
        __syncthreads();
        lru_chunk<true>(a, lds, item, tid);
        __syncthreads();
        const int tok0 = (item >> 6) * SEQ + (item & 63) * 64;
        const int nb = lane >> 3, c8 = 8 * (lane & 7);
        const f32x4 gr0 = *(const f32x4*)(a.g_rec + 8 * lane), gr1 = *(const f32x4*)(a.g_rec + 8 * lane + 4);
        const f32x4 ga0 = *(const f32x4*)(a.g_att + 8 * lane), ga1 = *(const f32x4*)(a.g_att + 8 * lane + 4);
        {
            u32x4 gwv[8];
#pragma unroll
            for (int ti = 0; ti < 8; ++ti) gwv[ti] = __builtin_nontemporal_load((const u32x4*)(PROJ + ((size_t)tok0 + 8 * wave + ti) * NIN + 2048 + 8 * lane));
#pragma unroll
            for (int ti = 0; ti < 8; ++ti) {
                const int tt = 8 * wave + ti; const size_t tok = (size_t)tok0 + tt;
                const LAS float* hp = (const LAS float*)lds + nb * (64 * XCS) + tt * XCS + c8;
                const f32x4 h0 = *(const LAS f32x4*)hp, h1 = *(const LAS f32x4*)(hp + 4);
                const u32x4 gw_ = gwv[ti];
                float rv[8];
                rv[0] = h0[0] * gelu_tanh(bf_lo(gw_.x)); rv[1] = h0[1] * gelu_tanh(bf_hi(gw_.x)); rv[2] = h0[2] * gelu_tanh(bf_lo(gw_.y)); rv[3] = h0[3] * gelu_tanh(bf_hi(gw_.y));
                rv[4] = h1[0] * gelu_tanh(bf_lo(gw_.z)); rv[5] = h1[1] * gelu_tanh(bf_hi(gw_.z)); rv[6] = h1[2] * gelu_tanh(bf_lo(gw_.w)); rv[7] = h1[3] * gelu_tanh(bf_hi(gw_.w));
                float ss = 0.f;
#pragma unroll
                for (int j = 0; j < 8; ++j) ss += rv[j] * rv[j];
                const float rn = rsqrtf(wave_sum(ss) * (1.f / 512.f) + EPS);
                u32x4 wr_; wr_.x = pk2(rv[0] * rn * gr0[0], rv[1] * rn * gr0[1]); wr_.y = pk2(rv[2] * rn * gr0[2], rv[3] * rn * gr0[3]);
                wr_.z = pk2(rv[4] * rn * gr1[0], rv[5] * rn * gr1[1]); wr_.w = pk2(rv[6] * rn * gr1[2], rv[7] * rn * gr1[3]);
                *(u32x4*)(MIX + tok * DM + 512 + 8 * lane) = wr_;
            }
#pragma unroll
            for (int th = 0; th < 2; ++th) {
                u32x4 ov[4][3]; float lg[4][3];
#pragma unroll
                for (int q = 0; q < 4; ++q) { const size_t tok = (size_t)tok0 + 8 * wave + 4 * th + q;
#pragma unroll
                    for (int g = 0; g < 3; ++g) { lg[q][g] = __builtin_nontemporal_load(LS + ((size_t)g * MTOK + tok) * 8 + nb); ov[q][g] = __builtin_nontemporal_load((const u32x4*)(OB + ((size_t)g * MTOK + tok) * 512 + 8 * lane)); } }
#pragma unroll
                for (int q = 0; q < 4; ++q) { const size_t tok = (size_t)tok0 + 8 * wave + 4 * th + q;
                    float av[8]; float lt = 0.f;
#pragma unroll
                    for (int j = 0; j < 8; ++j) av[j] = 0.f;
#pragma unroll
                    for (int g = 0; g < 3; ++g) { const float l_ = lg[q][g]; const u32x4 o_ = ov[q][g]; lt += l_;
                        av[0] += l_ * bf_lo(o_.x); av[1] += l_ * bf_hi(o_.x); av[2] += l_ * bf_lo(o_.y); av[3] += l_ * bf_hi(o_.y);
                        av[4] += l_ * bf_lo(o_.z); av[5] += l_ * bf_hi(o_.z); av[6] += l_ * bf_lo(o_.w); av[7] += l_ * bf_hi(o_.w); }
                    const float il = 1.0f / lt; float sa = 0.f;
#pragma unroll
                    for (int j = 0; j < 8; ++j) { av[j] *= il; sa += av[j] * av[j]; }
                    const float an = rsqrtf(wave_sum(sa) * (1.f / 512.f) + EPS);
                    u32x4 wa; wa.x = pk2(av[0] * an * ga0[0], av[1] * an * ga0[1]); wa.y = pk2(av[2] * an * ga0[2], av[3] * an * ga0[3]);
                    wa.z = pk2(av[4] * an * ga1[0], av[5] * an * ga1[1]); wa.w = pk2(av[6] * an * ga1[2], av[7] * an * ga1[3]);
                    *(u32x4*)(MIX + tok * DM + 8 * lane) = wa;
                }
            }
        }
    } }
    GSYNC();

    {
        pg8::Gemm g{MIX, WOUT, MTOK, DM, DM}; pg8::StaticOrder S; S.init(MTOK, DM, G, bid);
        pg8::EpiResid E{XN, XN, RS};
        pg8::gemm_phase<pg8::EpiResid, pg8::StaticOrder, true, true>(lds, g, S, E, wave);
    }
    GSYNC();

    for (int rep = 0; rep < REP_P5; ++rep) {
        if (rep) GSYNC();
        pg8::Gemm g{XN, WUP, MTOK, NUP, DM}; pg8::StaticOrder S; S.init(MTOK, NUP, G, bid, REPG_P5);
        pg8::EpiConvAct E{RS, a.fcw, a.fcb, ACT, HT, HB, lds + XLDS_OFF};
        pg8::gemm_phase<pg8::EpiConvAct, pg8::StaticOrder, true, true>(lds, g, S, E, wave);
    }
    GSYNC();

    {
        FRESH_TID();
        pg8::StaticOrder S0; S0.init(MTOK, DM, G, bid); pg8::Unit u0;
        for (int ui = 0; S0.next(ui, u0); ++ui) {
            const int pm = u0.pm;
            for (int v = tid; v < DFF / 4; v += 512) {
                const int c = 4 * v;
                f32x4 cv[2][2];
#pragma unroll
                for (int bj = 0; bj < 2; ++bj) {
                    const f32x4 t0 = *(const f32x4*)(HT + ((size_t)(pm * 2 + 0) * 2 + bj) * DFF + c), t1 = *(const f32x4*)(HT + ((size_t)(pm * 2 + 1) * 2 + bj) * DFF + c);
                    f32x4 b0 = (f32x4){0.f, 0.f, 0.f, 0.f}, b1 = b0;
                    if ((pm & 15) != 0) { b0 = *(const f32x4*)(HB + ((size_t)((pm - 1) * 2 + 0) * 2 + bj) * DFF + c); b1 = *(const f32x4*)(HB + ((size_t)((pm - 1) * 2 + 1) * 2 + bj) * DFF + c); }
                    const int col = bj * DFF + c;
                    const f32x4 w0 = *(const f32x4*)(a.fcw + col), w1 = *(const f32x4*)(a.fcw + NUP + col), w2 = *(const f32x4*)(a.fcw + 2 * NUP + col), bb = *(const f32x4*)(a.fcb + col);
                    cv[bj][0] = bb + w0 * b0 + w1 * b1 + w2 * t0;
                    cv[bj][1] = bb + w0 * b1 + w1 * t0 + w2 * t1;
                }
#pragma unroll
                for (int rr = 0; rr < 2; ++rr) { u32x2 wv;
                    wv.x = pk2(gelu_tanh(cv[0][rr][0]) * cv[1][rr][0], gelu_tanh(cv[0][rr][1]) * cv[1][rr][1]);
                    wv.y = pk2(gelu_tanh(cv[0][rr][2]) * cv[1][rr][2], gelu_tanh(cv[0][rr][3]) * cv[1][rr][3]);
                    *(u32x2*)(ACT + (size_t)(pm * 256 + rr) * DFF + c) = wv; }
            }
        }
        asm volatile("s_waitcnt vmcnt(0)" ::: "memory");
        __syncthreads();
    }

    {
        pg8::Gemm g{ACT, WDN, MTOK, DM, DFF}; pg8::StaticOrder S; S.init(MTOK, DM, G, bid);
        pg8::EpiDown E{XN, a.out};
        pg8::gemm_phase<pg8::EpiDown, pg8::StaticOrder, true, true>(lds, g, S, E, wave);
    }
    (void)OB; (void)LS;
}

extern "C" void kernel_launch(void* const* d_in, const int* in_sizes, int n_in, void* d_out, int out_size, void* d_ws, size_t ws_size, hipStream_t stream) {
    static int grid_blocks = 0;
    if (grid_blocks == 0) {
        if (n_in != 21 || ws_size < WS_END) { fprintf(stderr, "kernel_launch: unexpected inputs (n_in %d, ws %zu)\n", n_in, ws_size); grid_blocks = -1; return; }
        int dev = 0, cus = 0, per_cu = 0;
        hipGetDevice(&dev);
        hipDeviceGetAttribute(&cus, hipDeviceAttributeMultiprocessorCount, dev);
        hipFuncSetAttribute((const void*)fwd_kernel, hipFuncAttributeMaxDynamicSharedMemorySize, LDS_BYTES);
        hipOccupancyMaxActiveBlocksPerMultiprocessor(&per_cu, (const void*)fwd_kernel, 512, LDS_BYTES);
        if (per_cu < 1) per_cu = 1;
        grid_blocks = cus * per_cu;
        if (grid_blocks > 256) grid_blocks = 256;
        (void)hipGetLastError();
    }
    if (grid_blocks < 0) return;
    Args a{};
    a.x = (const float*)d_in[0]; a.pos = (const int*)d_in[1]; a.g_mix = (const float*)d_in[2]; a.w_in = (const float*)d_in[3];
    a.qg = (const float*)d_in[4]; a.kg = (const float*)d_in[5]; a.rcw = (const float*)d_in[6]; a.rcb = (const float*)d_in[7];
    a.w_rg = (const float*)d_in[8]; a.b_rg = (const float*)d_in[9]; a.w_ig = (const float*)d_in[10]; a.b_ig = (const float*)d_in[11];
    a.lam = (const float*)d_in[12]; a.g_att = (const float*)d_in[13]; a.g_rec = (const float*)d_in[14]; a.w_out = (const float*)d_in[15];
    a.g_ffn = (const float*)d_in[16]; a.w_up = (const float*)d_in[17]; a.fcw = (const float*)d_in[18]; a.fcb = (const float*)d_in[19];
    a.w_down = (const float*)d_in[20];
    a.out = (float*)d_out; a.ws = (unsigned char*)d_ws;
    (void)hipMemsetAsync(d_ws, 0, WS_ZERO_BYTES, stream);
    void* args[] = {&a};
    hipError_t e = hipLaunchCooperativeKernel((const void*)fwd_kernel, dim3(grid_blocks), dim3(512), args, LDS_BYTES, stream);
    if (e != hipSuccess) fprintf(stderr, "cooperative launch failed: %s (grid %d)\n", hipGetErrorString(e), grid_blocks);
}
```

```cpp
#include <hip/hip_runtime.h>
#include <hip/hip_cooperative_groups.h>
#include <cstdio>
#include <cstdint>
namespace cg = cooperative_groups;
#ifndef REP_SYNC
#define REP_SYNC 0
#endif
#ifndef REP_P0
#define REP_P0 1
#endif
#ifndef REP_P1
#define REP_P1 1
#endif
#ifndef REP_LRUA
#define REP_LRUA 1
#endif
#ifndef REP_P2
#define REP_P2 1
#endif
#ifndef REP_P3
#define REP_P3 1
#endif
#ifndef REP_P5
#define REP_P5 1
#endif
#ifndef REPG_P1
#define REPG_P1 1
#endif
#ifndef REPG_P5
#define REPG_P5 1
#endif
#ifndef REPI_P2
#define REPI_P2 1
#endif

#define LAS __attribute__((address_space(3)))
typedef unsigned short bf16_t;
typedef short bf16x8 __attribute__((ext_vector_type(8)));
typedef float f32x4 __attribute__((ext_vector_type(4)));
typedef float f32x2 __attribute__((ext_vector_type(2)));
typedef unsigned u32x4 __attribute__((ext_vector_type(4)));
typedef unsigned u32x2 __attribute__((ext_vector_type(2)));

constexpr int MTOK = 16384, SEQ = 4096, DM = 1024, NIN = 2560, DFF = 3072, NUP = 6144;
constexpr float EPS = 1e-6f;
constexpr float LOG2E = 1.4426950408889634f;

constexpr size_t MiB = 1u << 20;
constexpr size_t WS_RS = 0;
constexpr size_t WS_BAR = 65536;
constexpr size_t WS_RS0 = 262144;
constexpr size_t WS_CHS = 1 * MiB;
constexpr size_t WS_CS = 2 * MiB;
constexpr size_t WS_LSUM = 6 * MiB;
constexpr size_t WS_WG = 7 * MiB + 512 * 1024;
constexpr size_t WS_ZERO_BYTES = 131072;
constexpr size_t WS_WIN = 8 * MiB;
constexpr size_t WS_WOUT = 13 * MiB;
constexpr size_t WS_WDN = 15 * MiB;
constexpr size_t WS_WUP = 21 * MiB;
constexpr size_t WS_HT = 33 * MiB;
constexpr size_t WS_HB = 36 * MiB;
constexpr size_t WS_XN = 40 * MiB;
constexpr size_t WS_PROJ = 72 * MiB;
constexpr size_t WS_OB = 152 * MiB;
constexpr size_t WS_MIX = 200 * MiB;
constexpr size_t WS_ACT = 72 * MiB;
constexpr size_t WS_END = 232 * MiB;

constexpr int LDS_BYTES = 155648;
constexpr int XLDS_OFF = 131072;
constexpr int MISC_OFF = 155648 - 64;

__device__ __forceinline__ unsigned f2bf(float f) { unsigned u = __builtin_bit_cast(unsigned, f); return (u + 0x7fffu + ((u >> 16) & 1u)) >> 16; }
__device__ __forceinline__ unsigned pk2(float lo, float hi) { unsigned r; asm("v_cvt_pk_bf16_f32 %0, %1, %2" : "=v"(r) : "v"(lo), "v"(hi)); return r; }
__device__ __forceinline__ float bf_lo(unsigned w) { return __builtin_bit_cast(float, w << 16); }
__device__ __forceinline__ float bf_hi(unsigned w) { return __builtin_bit_cast(float, w & 0xffff0000u); }
__device__ __forceinline__ float bf2f(bf16_t h) { return __builtin_bit_cast(float, (unsigned)h << 16); }
__device__ __forceinline__ float fast_exp2(float x) { return __builtin_amdgcn_exp2f(x); }
__device__ __forceinline__ float fast_rcp(float x) { return __builtin_amdgcn_rcpf(x); }
__device__ __forceinline__ float sigmoidf_(float z) { return fast_rcp(1.f + fast_exp2(-z * LOG2E)); }
__device__ __forceinline__ float gelu_tanh(float x) { const float t = x * fmaf(x * x, -2.f * LOG2E * 0.7978845608028654f * 0.044715f, -2.f * LOG2E * 0.7978845608028654f); return x * fast_rcp(1.f + fast_exp2(t)); }
__device__ __forceinline__ float wave_sum(float v) {
#pragma unroll
    for (int o = 1; o < 64; o <<= 1) v += __shfl_xor(v, o);
    return v;
}
__device__ __forceinline__ float wave_max(float v) {
#pragma unroll
    for (int o = 1; o < 64; o <<= 1) v = fmaxf(v, __shfl_xor(v, o));
    return v;
}
__device__ __forceinline__ int fresh_lane() { int l; asm volatile("v_mbcnt_lo_u32_b32 %0, -1, 0\n\tv_mbcnt_hi_u32_b32 %0, -1, %0" : "=v"(l)); return l; }
template <int CTRL> __device__ __forceinline__ float dpp_f(float old, float src) {
    return __builtin_bit_cast(float, __builtin_amdgcn_update_dpp(__builtin_bit_cast(int, old), __builtin_bit_cast(int, src), CTRL, 0xF, 0xF, false));
}

namespace pg8 {
constexpr int BM = 256, BK = 64, HALF = 128, HTB = HALF * BK * 2, STAGE_BYTES = 8 * HTB, NXCD = 8, WGM = 8;
__host__ __device__ __forceinline__ int lds_byte(int r, int c) { const int st = (r >> 4) * 2 + (c >> 5), rr = r & 15, cc = c & 31, ob = rr * 64 + cc * 2; return st * 1024 + (ob ^ (((ob >> 9) & 1) << 5)); }
__host__ __device__ __forceinline__ void stage_rc(int b, int& R, int& C) { const int st = b / 1024, sb = b % 1024, swz = sb ^ (((sb >> 9) & 1) << 5); R = (st >> 1) * 16 + swz / 64; C = (st & 1) * 32 + (swz % 64) / 2; }
__host__ __device__ __forceinline__ int perm32(int rho) { const int n = rho >> 4, i = rho & 15; return 8 * (i >> 2) + 4 * n + (i & 3); }

struct Unit { int pm, pn; };
struct Gemm { const bf16_t* A; const bf16_t* Bt; int M, N, K; };

struct StaticOrder {
    int nM, nN, nwg, G, c, tot;
    __host__ __device__ void init(int M, int N, int G_, int c_, int repf = 1) { nM = M / BM; nN = N / BM; nwg = nM * nN; G = G_; c = c_; tot = nwg * repf; }
    __host__ __device__ bool next(int i, Unit& u) const {
        const long L = (long)i * G + c; if (L >= tot) return false;
        int wgid = (int)(L % nwg); { const int q = nwg / NXCD, r = nwg % NXCD, xcd = wgid % NXCD, off = wgid / NXCD; wgid = (xcd < r ? xcd * (q + 1) : r * (q + 1) + (xcd - r) * q) + off; }
        const int nig = WGM * nN, gid = wgid / nig, fm = gid * WGM, gsz = (nM - fm) < WGM ? (nM - fm) : WGM;
        u.pm = fm + ((wgid % nig) % gsz); u.pn = (wgid % nig) / gsz; return true;
    }
};

__device__ __forceinline__ unsigned cvt_pk_bf16(float lo, float hi) { unsigned r; asm volatile("v_cvt_pk_bf16_f32 %0, %1, %2" : "=v"(r) : "v"(lo), "v"(hi)); return r; }

template <class Epi, class Sched, bool ALIGN_EPI = false, bool SP2 = false>
__device__ __forceinline__ void gemm_phase(LAS unsigned char* lds, const Gemm g, const Sched& S, const Epi& E, int wid) {
    const int lane = fresh_lane(), tid = wid * 64 + lane, wr = wid >> 2, wc = wid & 3, fr = lane & 15, fq = lane >> 4;
    const int K = g.K, nt = K / BK;
    unsigned voffA[2], voffB[2];
#pragma unroll
    for (int i = 0; i < 2; ++i) { int R, C; stage_rc(tid * 16 + i * 8192, R, C); const int Rb = Epi::PERM ? ((R & ~31) + perm32(R & 31)) : R;
        voffA[i] = (unsigned)(R * K + C) * 2u; voffB[i] = (unsigned)(Rb * K + C) * 2u; }
    const size_t kstep = (size_t)(BK * 2);
    const size_t hstep = (size_t)HALF * K * 2;
    const size_t tstep = 2 * hstep;
    const unsigned ldsw = (unsigned)wid * 1024u;
    const int aoff = lds_byte(wr * 64 + fr, fq * 8), boff = lds_byte(wc * 32 + fr, fq * 8);
#define PG8_SA(b, h) (((b) * 2 + (h)) * HTB)
#define PG8_SB(b, h) ((4 + (b) * 2 + (h)) * HTB)
#define PG8_STAGE(bufoff, gbase, voff) do { _Pragma("unroll") for (int _i = 0; _i < 2; ++_i) \
        __builtin_amdgcn_global_load_lds((const unsigned*)((const char*)(gbase) + (voff)[_i]), (LAS unsigned*)(lds + (bufoff) + ldsw + _i * 8192), 16, 0, 0); } while (0)
#define PG8_LDA(dst, b, h) do { _Pragma("unroll") for (int m = 0; m < 4; ++m) _Pragma("unroll") for (int k = 0; k < 2; ++k) dst[m][k] = *(const LAS bf16x8*)(lds + PG8_SA(b, h) + aoff + m * 2048 + k * 1024); } while (0)
#define PG8_LDB(dst, b, h) do { _Pragma("unroll") for (int n = 0; n < 2; ++n) _Pragma("unroll") for (int k = 0; k < 2; ++k) dst[n][k] = *(const LAS bf16x8*)(lds + PG8_SB(b, h) + boff + n * 2048 + k * 1024); } while (0)
#define PG8_MMA(ai, bj, At, Bt) do { __builtin_amdgcn_s_setprio(1); _Pragma("unroll") for (int m = 0; m < 4; ++m) _Pragma("unroll") for (int n = 0; n < 2; ++n) _Pragma("unroll") for (int k = 0; k < 2; ++k) \
        acc[ai][bj][m][n] = __builtin_amdgcn_mfma_f32_16x16x32_bf16(Bt[n][k], At[m][k], acc[ai][bj][m][n], 0, 0, 0); __builtin_amdgcn_s_setprio(0); } while (0)
#define PG8_WAIT_V(n) asm volatile("s_waitcnt vmcnt(" #n ")" ::: "memory")
#define PG8_WAIT_L(n) asm volatile("s_waitcnt lgkmcnt(" #n ")" ::: "memory")
#define PG8_BAR __builtin_amdgcn_s_barrier()
#define PG8_SCHED __builtin_amdgcn_sched_barrier(0)
    Unit cur, nxt; int ui = 0;
    if (!S.next(0, cur)) return;
    f32x4 acc[2][2][4][2];
#pragma unroll
    for (int a = 0; a < 2; ++a)
#pragma unroll
        for (int b = 0; b < 2; ++b)
#pragma unroll
            for (int m = 0; m < 4; ++m)
#pragma unroll
                for (int n = 0; n < 2; ++n) acc[a][b][m][n] = (f32x4){0.f, 0.f, 0.f, 0.f};
    bf16x8 At[4][2], B0[2][2], B1[2][2];
    const char* cA = (const char*)g.A + (size_t)cur.pm * tstep; const char* cB = (const char*)g.Bt + (size_t)cur.pn * tstep;
    typename Epi::State est = E.pre(cur, wr, fr, fq);
    if constexpr (SP2) {
        PG8_STAGE(PG8_SB(0, 0), cB, voffB); PG8_STAGE(PG8_SB(0, 1), cB + hstep, voffB); PG8_STAGE(PG8_SA(0, 0), cA, voffA); PG8_STAGE(PG8_SA(0, 1), cA + hstep, voffA);
        if (wr == 1) PG8_BAR;
        PG8_WAIT_V(2); PG8_BAR;
        PG8_STAGE(PG8_SB(1, 0), cB + kstep, voffB); PG8_STAGE(PG8_SA(1, 0), cA + kstep, voffA); PG8_STAGE(PG8_SB(1, 1), cB + hstep + kstep, voffB);
        PG8_WAIT_V(6); PG8_BAR;
    } else {
        PG8_STAGE(PG8_SB(0, 0), cB, voffB); PG8_STAGE(PG8_SA(0, 0), cA, voffA); PG8_STAGE(PG8_SB(0, 1), cB + hstep, voffB); PG8_STAGE(PG8_SA(0, 1), cA + hstep, voffA);
        if (wr == 1) PG8_BAR;
        PG8_WAIT_V(4); PG8_BAR;
        PG8_STAGE(PG8_SB(1, 0), cB + kstep, voffB); PG8_STAGE(PG8_SA(1, 0), cA + kstep, voffA); PG8_STAGE(PG8_SB(1, 1), cB + hstep + kstep, voffB);
        PG8_WAIT_V(6); PG8_BAR;
    }
    for (;;) {
        const bool has_next = S.next(ui + 1, nxt);
        const char* nA = has_next ? (const char*)g.A + (size_t)nxt.pm * tstep : cA; const char* nB = has_next ? (const char*)g.Bt + (size_t)nxt.pn * tstep : cB;
        for (int t = 0; t < nt; t += 2) {
            const bool last = (t == nt - 2);
            const char* a1 = cA + (size_t)(t + 1) * kstep;
            const char* a2 = last ? nA : cA + (size_t)(t + 2) * kstep; const char* b2 = last ? nB : cB + (size_t)(t + 2) * kstep;
            const char* a3 = a2 + kstep; const char* b3 = b2 + kstep;
            if constexpr (SP2) {
            PG8_LDB(B0, 0, 0); PG8_LDB(B1, 0, 1); PG8_SCHED; PG8_LDA(At, 0, 0); PG8_STAGE(PG8_SA(1, 1), a1 + hstep, voffA);
            PG8_WAIT_V(8); PG8_WAIT_L(0); PG8_BAR; PG8_MMA(0, 0, At, B0); PG8_MMA(0, 1, At, B1); PG8_BAR; PG8_SCHED;
            PG8_LDA(At, 0, 1); PG8_STAGE(PG8_SB(0, 0), b2, voffB); PG8_STAGE(PG8_SB(0, 1), b2 + hstep, voffB); PG8_STAGE(PG8_SA(0, 0), a2, voffA);
            PG8_WAIT_V(8); PG8_WAIT_L(0); PG8_BAR; PG8_MMA(1, 0, At, B0); PG8_MMA(1, 1, At, B1); PG8_BAR; PG8_SCHED;
            PG8_LDB(B0, 1, 0); PG8_LDB(B1, 1, 1); PG8_SCHED; PG8_LDA(At, 1, 0); PG8_STAGE(PG8_SA(0, 1), a2 + hstep, voffA);
            PG8_WAIT_V(8); PG8_WAIT_L(0); PG8_BAR; PG8_MMA(0, 0, At, B0); PG8_MMA(0, 1, At, B1); PG8_BAR; PG8_SCHED;
            PG8_LDA(At, 1, 1); PG8_STAGE(PG8_SB(1, 0), b3, voffB); PG8_STAGE(PG8_SB(1, 1), b3 + hstep, voffB); PG8_STAGE(PG8_SA(1, 0), a3, voffA);
            PG8_WAIT_V(8); PG8_WAIT_L(0); PG8_BAR; PG8_MMA(1, 0, At, B0); PG8_MMA(1, 1, At, B1); PG8_BAR; PG8_SCHED;
            } else {
            PG8_LDB(B0, 0, 0); PG8_SCHED; PG8_LDA(At, 0, 0); PG8_STAGE(PG8_SA(1, 1), a1 + hstep, voffA);
            PG8_WAIT_L(8); PG8_BAR; PG8_WAIT_L(0); PG8_MMA(0, 0, At, B0); PG8_BAR; PG8_SCHED;
            PG8_LDB(B1, 0, 1); PG8_STAGE(PG8_SB(0, 0), b2, voffB);
            PG8_BAR; PG8_WAIT_L(0); PG8_MMA(0, 1, At, B1); PG8_BAR;
            PG8_LDA(At, 0, 1); PG8_STAGE(PG8_SA(0, 0), a2, voffA);
            PG8_BAR; PG8_WAIT_L(0); PG8_MMA(1, 0, At, B0); PG8_BAR; PG8_SCHED;
            PG8_STAGE(PG8_SB(0, 1), b2 + hstep, voffB);
            PG8_WAIT_V(6); PG8_BAR; PG8_MMA(1, 1, At, B1); PG8_BAR;
            PG8_LDB(B0, 1, 0); PG8_SCHED; PG8_LDA(At, 1, 0); PG8_STAGE(PG8_SA(0, 1), a2 + hstep, voffA);
            PG8_WAIT_L(8); PG8_BAR; PG8_WAIT_L(0); PG8_MMA(0, 0, At, B0); PG8_BAR; PG8_SCHED;
            PG8_LDB(B1, 1, 1); PG8_STAGE(PG8_SB(1, 0), b3, voffB);
            PG8_BAR; PG8_WAIT_L(0); PG8_MMA(0, 1, At, B1); PG8_BAR;
            PG8_LDA(At, 1, 1); PG8_STAGE(PG8_SA(1, 0), a3, voffA);
            PG8_BAR; PG8_WAIT_L(0); PG8_MMA(1, 0, At, B0); PG8_BAR; PG8_SCHED;
            PG8_STAGE(PG8_SB(1, 1), b3 + hstep, voffB);
            PG8_WAIT_V(6); PG8_BAR; PG8_MMA(1, 1, At, B1); PG8_BAR;
            }
        }
        if constexpr (ALIGN_EPI) { if (wr == 0) PG8_BAR; }
        E(acc, cur, wr, wc, fr, fq, est);
        if (!has_next) break;
#pragma unroll
        for (int a = 0; a < 2; ++a)
#pragma unroll
            for (int b = 0; b < 2; ++b)
#pragma unroll
                for (int m = 0; m < 4; ++m)
#pragma unroll
                    for (int n = 0; n < 2; ++n) acc[a][b][m][n] = (f32x4){0.f, 0.f, 0.f, 0.f};
        cur = nxt; cA = nA; cB = nB; ++ui;
        est = E.pre(cur, wr, fr, fq);
        if constexpr (ALIGN_EPI) { if (wr == 1) PG8_BAR; }
    }
    PG8_WAIT_V(0);
    if constexpr (!ALIGN_EPI) { if (wr == 0) PG8_BAR; }
    PG8_BAR;
#undef PG8_SA
#undef PG8_SB
#undef PG8_STAGE
#undef PG8_LDA
#undef PG8_LDB
#undef PG8_MMA
#undef PG8_WAIT_V
#undef PG8_WAIT_L
#undef PG8_BAR
#undef PG8_SCHED
}

struct EpiStoreBf16 {
    static constexpr bool PERM = true;
    struct State { float ss[2][4]; };
    bf16_t* O; int ldc; const float* SS;
    __device__ __forceinline__ State pre(const Unit& u, int wr, int fr, int fq) const { State st;
#pragma unroll
        for (int ai = 0; ai < 2; ++ai)
#pragma unroll
            for (int m = 0; m < 4; ++m) st.ss[ai][m] = SS[u.pm * BM + ai * HALF + wr * 64 + m * 16 + fr];
        return st; }
    __device__ __forceinline__ void operator()(const f32x4 (&acc)[2][2][4][2], const Unit& u, int wr, int wc, int fr, int fq, const State& st) const {
        const int row0 = u.pm * BM + wr * 64 + fr, col0 = u.pn * BM + wc * 32 + 8 * fq;
#pragma unroll
        for (int ai = 0; ai < 2; ++ai)
#pragma unroll
            for (int m = 0; m < 4; ++m) { bf16_t* rowp = O + (size_t)(row0 + ai * HALF + m * 16) * ldc + col0;
                const float rs = rsqrtf(st.ss[ai][m] * (1.0f / DM) + EPS);
#pragma unroll
                for (int bj = 0; bj < 2; ++bj) { const f32x4 v0 = acc[ai][bj][m][0] * rs, v1 = acc[ai][bj][m][1] * rs;
                    u32x4 w; w.x = cvt_pk_bf16(v0[0], v0[1]); w.y = cvt_pk_bf16(v0[2], v0[3]); w.z = cvt_pk_bf16(v1[0], v1[1]); w.w = cvt_pk_bf16(v1[2], v1[3]);
                    *(u32x4*)(rowp + bj * HALF) = w; } }
    }
};

struct EpiResid {
    static constexpr bool PERM = true;
    struct State {}; __device__ __forceinline__ State pre(const Unit&, int, int, int) const { return State{}; }
    const bf16_t* XB; bf16_t* XN; float* RS;
    __device__ __forceinline__ void operator()(const f32x4 (&acc)[2][2][4][2], const Unit& u, int wr, int wc, int fr, int fq, const State&) const {
        const int row0 = u.pm * BM + wr * 64 + fr, col0 = u.pn * BM + wc * 32 + 8 * fq;
#pragma unroll
        for (int ai = 0; ai < 2; ++ai)
#pragma unroll
            for (int m = 0; m < 4; ++m) { const int row = row0 + ai * HALF + m * 16; const size_t ro = (size_t)row * DM + col0; float ss = 0.f;
#pragma unroll
                for (int bj = 0; bj < 2; ++bj) {
                    const u32x4 xw = *(const u32x4*)(XB + ro + bj * HALF);
                    const f32x4 x0 = (f32x4){bf_lo(xw.x), bf_hi(xw.x), bf_lo(xw.y), bf_hi(xw.y)}, x1 = (f32x4){bf_lo(xw.z), bf_hi(xw.z), bf_lo(xw.w), bf_hi(xw.w)};
                    const f32x4 v0 = acc[ai][bj][m][0] + x0, v1 = acc[ai][bj][m][1] + x1;
                    ss += (v0[0] * v0[0] + v0[1] * v0[1]) + (v0[2] * v0[2] + v0[3] * v0[3]) + (v1[0] * v1[0] + v1[1] * v1[1]) + (v1[2] * v1[2] + v1[3] * v1[3]);
                    u32x4 w; w.x = cvt_pk_bf16(v0[0], v0[1]); w.y = cvt_pk_bf16(v0[2], v0[3]); w.z = cvt_pk_bf16(v1[0], v1[1]); w.w = cvt_pk_bf16(v1[2], v1[3]);
                    *(u32x4*)(XN + ro + bj * HALF) = w; }
                ss += __shfl_xor(ss, 16); ss += __shfl_xor(ss, 32);
                if (fq == 0) atomicAdd(RS + row, ss); }
    }
};

struct EpiDown {
    static constexpr bool PERM = true;
    struct State {}; __device__ __forceinline__ State pre(const Unit&, int, int, int) const { return State{}; }
    const bf16_t* X1; float* OUT;
    __device__ __forceinline__ void operator()(const f32x4 (&acc)[2][2][4][2], const Unit& u, int wr, int wc, int fr, int fq, const State&) const {
        const int row0 = u.pm * BM + wr * 64 + fr, col0 = u.pn * BM + wc * 32 + 8 * fq;
#pragma unroll
        for (int ai = 0; ai < 2; ++ai)
#pragma unroll
            for (int m = 0; m < 4; ++m) { const size_t ro = (size_t)(row0 + ai * HALF + m * 16) * DM + col0;
#pragma unroll
                for (int bj = 0; bj < 2; ++bj) {
                    const u32x4 xw = *(const u32x4*)(X1 + ro + bj * HALF);
                    const f32x4 x0 = (f32x4){bf_lo(xw.x), bf_hi(xw.x), bf_lo(xw.y), bf_hi(xw.y)}, x1 = (f32x4){bf_lo(xw.z), bf_hi(xw.z), bf_lo(xw.w), bf_hi(xw.w)};
                    __builtin_nontemporal_store(acc[ai][bj][m][0] + x0, (f32x4*)(OUT + ro + bj * HALF)); __builtin_nontemporal_store(acc[ai][bj][m][1] + x1, (f32x4*)(OUT + ro + bj * HALF + 4)); } }
    }
};

struct EpiConvAct {
    static constexpr bool PERM = true;
    struct State { float rs[4]; };
    __device__ __forceinline__ State pre(const Unit& u, int wr, int fr, int fq) const { State st;
#pragma unroll
        for (int m = 0; m < 4; ++m) st.rs[m] = RS[u.pm * BM + (fq & 1) * HALF + wr * 64 + m * 16 + fr];
        return st; }
    const float* RS; const float* CW; const float* CB; bf16_t* ACT; float* HT; float* HB; LAS unsigned char* xlds;
    __device__ __forceinline__ static int xidx(int ai, int wr, int wc, int rsel, int bj, int n, int fq) { return ((((((ai * 2 + wr) * 4 + wc) * 2 + rsel) * 2 + bj) * 2 + n) * 4 + fq); }
    __device__ __forceinline__ void operator()(const f32x4 (&acc)[2][2][4][2], const Unit& u, int wr, int wc, int fr, int fq, const State& st) const {
        asm volatile("" : "+v"(fr), "+v"(fq));
        LAS f32x4* X = (LAS f32x4*)xlds;
        LAS float* RSL = (LAS float*)(xlds + 8192) + (wr * 4 + wc) * 128;
        if (fq < 2) {
#pragma unroll
            for (int m = 0; m < 4; ++m) RSL[(fq * 4 + m) * 16 + fr] = rsqrtf(st.rs[m] * (1.0f / DM) + EPS);
        }
        asm volatile("s_waitcnt lgkmcnt(0)" ::: "memory");
        if (fr >= 14) {
#pragma unroll
            for (int ai = 0; ai < 2; ++ai) { const float r3 = RSL[(ai * 4 + 3) * 16 + fr];
#pragma unroll
                for (int bj = 0; bj < 2; ++bj)
#pragma unroll
                    for (int n = 0; n < 2; ++n) X[xidx(ai, wr, wc, fr - 14, bj, n, fq)] = acc[ai][bj][3][n] * r3; }
        }
        __syncthreads();
        const int cbase = u.pn * HALF + wc * 32 + 8 * fq;
        f32x2 W0[2][4], W1[2][4], W2[2][4], BB[2][4];
#pragma unroll
        for (int n = 0; n < 2; ++n) {
            const int c = cbase + 4 * n;
            const f32x4 wg0 = *(const f32x4*)(CW + c), wg1 = *(const f32x4*)(CW + NUP + c), wg2 = *(const f32x4*)(CW + 2 * NUP + c), bg = *(const f32x4*)(CB + c);
            const f32x4 wu0 = *(const f32x4*)(CW + DFF + c), wu1 = *(const f32x4*)(CW + NUP + DFF + c), wu2 = *(const f32x4*)(CW + 2 * NUP + DFF + c), bu = *(const f32x4*)(CB + DFF + c);
#pragma unroll
            for (int e = 0; e < 4; ++e) { W0[n][e] = (f32x2){wg0[e], wu0[e]}; W1[n][e] = (f32x2){wg1[e], wu1[e]}; W2[n][e] = (f32x2){wg2[e], wu2[e]}; BB[n][e] = (f32x2){bg[e], bu[e]}; }
        }
#pragma unroll
        for (int ai = 0; ai < 2; ++ai) {
            f32x2 pp[2][4];
#pragma unroll
            for (int n = 0; n < 2; ++n)
#pragma unroll
                for (int e = 0; e < 4; ++e) pp[n][e] = (f32x2){0.f, 0.f};
            if (wr == 1 || ai == 1) {
                const int sa = (wr == 1) ? ai : 0, sw = (wr == 1) ? 0 : 1;
                if (fr >= 14) {
#pragma unroll
                    for (int n = 0; n < 2; ++n) { const f32x4 tg = X[xidx(sa, sw, wc, fr - 14, 0, n, fq)], tu = X[xidx(sa, sw, wc, fr - 14, 1, n, fq)];
#pragma unroll
                        for (int e = 0; e < 4; ++e) pp[n][e] = (f32x2){tg[e], tu[e]}; }
                }
            }
#pragma unroll
            for (int m = 0; m < 4; ++m) {
                const float rsv = RSL[(ai * 4 + m) * 16 + fr];
                const int row = u.pm * BM + ai * HALF + wr * 64 + m * 16 + fr;
                const bool edge0 = (ai == 0 && wr == 0 && m == 0 && fr < 2);
                const bool edge1 = (ai == 1 && wr == 1 && m == 3 && fr >= 14);
                u32x4 wv;
#pragma unroll
                for (int n = 0; n < 2; ++n) {
                    const f32x4 ag = acc[ai][0][m][n], au = acc[ai][1][m][n];
                    f32x2 cur[4]; f32x4 o;
#pragma unroll
                    for (int e = 0; e < 4; ++e) {
                        cur[e] = (f32x2){ag[e], au[e]} * rsv;
                        f32x2 p1, p2;
                        p1.x = dpp_f<0x111>(dpp_f<0x121>(0.f, pp[n][e].x), cur[e].x); p1.y = dpp_f<0x111>(dpp_f<0x121>(0.f, pp[n][e].y), cur[e].y);
                        p2.x = dpp_f<0x112>(dpp_f<0x122>(0.f, pp[n][e].x), cur[e].x); p2.y = dpp_f<0x112>(dpp_f<0x122>(0.f, pp[n][e].y), cur[e].y);
                        const f32x2 v = BB[n][e] + W0[n][e] * p2 + W1[n][e] * p1 + W2[n][e] * cur[e];
                        o[e] = gelu_tanh(v.x) * v.y;
                    }
                    if (n == 0) { wv.x = cvt_pk_bf16(o[0], o[1]); wv.y = cvt_pk_bf16(o[2], o[3]); } else { wv.z = cvt_pk_bf16(o[0], o[1]); wv.w = cvt_pk_bf16(o[2], o[3]); }
                    if (edge0) {
                        *(f32x4*)(HT + ((size_t)(u.pm * 2 + fr) * 2 + 0) * DFF + cbase + 4 * n) = (f32x4){cur[0].x, cur[1].x, cur[2].x, cur[3].x};
                        *(f32x4*)(HT + ((size_t)(u.pm * 2 + fr) * 2 + 1) * DFF + cbase + 4 * n) = (f32x4){cur[0].y, cur[1].y, cur[2].y, cur[3].y}; }
                    if (edge1) {
                        *(f32x4*)(HB + ((size_t)(u.pm * 2 + fr - 14) * 2 + 0) * DFF + cbase + 4 * n) = (f32x4){cur[0].x, cur[1].x, cur[2].x, cur[3].x};
                        *(f32x4*)(HB + ((size_t)(u.pm * 2 + fr - 14) * 2 + 1) * DFF + cbase + 4 * n) = (f32x4){cur[0].y, cur[1].y, cur[2].y, cur[3].y}; }
#pragma unroll
                    for (int e = 0; e < 4; ++e) pp[n][e] = cur[e];
                }
                if (!edge0) *(u32x4*)(ACT + (size_t)row * DFF + cbase) = wv;
                __builtin_amdgcn_sched_barrier(0);
            }
        }
    }
};
}

#define XB_TMO      128
#define XB_XCNT(j)  (256  + 64 * (j))
#define XB_XSUB(j)  (1280 + 64 * (j))
#define XB_XGEN(j)  (2304 + 64 * (j))
#define XB_TOP      3328
#define XB_TOPGEN   3392
#define XCD_BAR_WORDS 3456
#define XB_SPIN_CAP (1u << 18)
__device__ __forceinline__ unsigned xb_ld(unsigned* p)              { return __hip_atomic_load(p, __ATOMIC_RELAXED, __HIP_MEMORY_SCOPE_AGENT); }
__device__ __forceinline__ unsigned xb_add(unsigned* p, unsigned v) { return __hip_atomic_fetch_add(p, v, __ATOMIC_RELAXED, __HIP_MEMORY_SCOPE_AGENT); }
__device__ __forceinline__ unsigned xb_xcc_id() { return (unsigned)__builtin_amdgcn_s_getreg((3 << 11) | 20) & 0xFu; }
#define XB_SPIN(cond, bar) do { unsigned _sp = 0; while (cond) { __builtin_amdgcn_s_sleep(1); \
    if ((++_sp & 255u) == 0u) { if (xb_ld(&(bar)[XB_TMO])) break; if (_sp > XB_SPIN_CAP) { atomicAdd(&(bar)[XB_TMO], 1u); break; } } } } while (0)
struct XcdBarrier { unsigned* bar; unsigned x; volatile LAS unsigned* st; };
__device__ __forceinline__ XcdBarrier xcd_barrier_post(unsigned* bar, volatile LAS unsigned* st) {
    XcdBarrier b; b.bar = bar; b.x = xb_xcc_id(); b.st = st;
    if (threadIdx.x == 0) (void)xb_add(&bar[XB_XCNT(b.x)], 1u);
    return b;
}
__device__ __forceinline__ void xcd_barrier_complete(unsigned* bar, unsigned x, unsigned& nloc, unsigned& nx) {
    const unsigned G = gridDim.x * gridDim.y * gridDim.z;
    unsigned sum, cnt, mine, sp = 0u;
    for (;;) {
        sum = 0u; cnt = 0u; mine = 0u;
#pragma unroll
        for (unsigned j = 0; j < 16; ++j) { const unsigned c = xb_ld(&bar[XB_XCNT(j)]); sum += c; cnt += (c > 0u) ? 1u : 0u; mine = (j == x) ? c : mine; }
        if (sum == G) break;
        __builtin_amdgcn_s_sleep(1);
        if ((++sp & 255u) == 0u) { if (xb_ld(&bar[XB_TMO])) break; if (sp > XB_SPIN_CAP) { atomicAdd(&bar[XB_TMO], 1u); break; } }
    }
    nloc = mine > 0u ? mine : 1u; nx = cnt > 0u ? cnt : 1u;
}
__device__ __forceinline__ void xcd_barrier(const XcdBarrier& b) {
    asm volatile("s_waitcnt vmcnt(0)" ::: "memory");
    __syncthreads();
    if (threadIdx.x == 0) {
        unsigned* bar = b.bar;
        __builtin_amdgcn_s_waitcnt(0);
        unsigned nloc = b.st[0], nx = b.st[1];
        if (nloc == 0u) { xcd_barrier_complete(bar, b.x, nloc, nx); b.st[0] = nloc; b.st[1] = nx; }
        const unsigned old = xb_add(&bar[XB_XSUB(b.x)], 1u);
        const unsigned gen = old / nloc;
        if (old + 1u == (gen + 1u) * nloc) {
            __builtin_amdgcn_fence(__ATOMIC_RELEASE, "agent");
            asm volatile("s_waitcnt vmcnt(0)" ::: "memory");
            const unsigned og = xb_add(&bar[XB_TOP], 1u);
            const unsigned tg = og / nx;
            if (og + 1u == (tg + 1u) * nx) xb_add(&bar[XB_TOPGEN], 1u);
            else XB_SPIN(xb_ld(&bar[XB_TOPGEN]) == tg, bar);
            __builtin_amdgcn_fence(__ATOMIC_ACQUIRE, "agent");
            xb_add(&bar[XB_XGEN(b.x)], 1u);
            asm volatile("s_waitcnt vmcnt(0)" ::: "memory");
        } else {
            XB_SPIN(xb_ld(&bar[XB_XGEN(b.x)]) == gen, bar);
            __builtin_amdgcn_fence(__ATOMIC_ACQUIRE, "agent");
            asm volatile("s_waitcnt vmcnt(0)" ::: "memory");
        }
    }
    __syncthreads();
}

struct Args {
    const float* x; const int* pos; const float* g_mix; const float* w_in; const float* qg; const float* kg; const float* rcw; const float* rcb;
    const float* w_rg; const float* b_rg; const float* w_ig; const float* b_ig; const float* lam; const float* g_att; const float* g_rec; const float* w_out;
    const float* g_ffn; const float* w_up; const float* fcw; const float* fcb; const float* w_down;
    float* out; unsigned char* ws;
};

__device__ __forceinline__ void transpose_item(const float* W, int K, int N, bf16_t* WT, LAS float* scr, int item, int lane, const float* kscale, bool permup) {
    const int nblk = N / 32, kb = item / nblk, nb = item % nblk, k0 = 64 * kb, n0 = 32 * nb;
    float tv[32];
#pragma unroll
    for (int i = 0; i < 32; ++i) { const int kk = 2 * i + (lane >> 5); tv[i] = __builtin_nontemporal_load(W + (size_t)(k0 + kk) * N + n0 + (lane & 31)); }
#pragma unroll
    for (int i = 0; i < 32; ++i) { const int kk = 2 * i + (lane >> 5); float v = tv[i]; if (kscale) v *= kscale[k0 + kk]; scr[kk * 33 + (lane & 31)] = v; }
    asm volatile("s_waitcnt lgkmcnt(0)" ::: "memory");
    const int c = lane & 7;
#pragma unroll
    for (int j = 0; j < 4; ++j) { const int n = (lane >> 3) + 8 * j; const LAS float* s = scr + (8 * c) * 33 + n;
        u32x4 o; o.x = pk2(s[0 * 33], s[1 * 33]); o.y = pk2(s[2 * 33], s[3 * 33]); o.z = pk2(s[4 * 33], s[5 * 33]); o.w = pk2(s[6 * 33], s[7 * 33]);
        int nn = n0 + n; if (permup) { const int bjs = nn / DFF, rem = nn % DFF; nn = (rem / 128) * 256 + bjs * 128 + (rem % 128); }
        *(u32x4*)(WT + (size_t)nn * K + k0 + 8 * c) = o; }
    asm volatile("s_waitcnt lgkmcnt(0)" ::: "memory");
}

constexpr int XCS = 68;
template <bool FINAL>
__device__ __forceinline__ void lru_chunk(const Args& a, LAS unsigned char* lds, int item, int tid) {
    const int lane = tid & 63, w = __builtin_amdgcn_readfirstlane(tid >> 6), fr = lane & 15, fq = lane >> 4;
    const int b = item >> 6, c = item & 63, tok0 = b * SEQ + c * 64;
    const bf16_t* PROJ = (const bf16_t*)(a.ws + WS_PROJ);
    float* CHA = (float*)(a.ws + WS_CHS); float* CHH = CHA + 4 * 64 * 512;
    LAS float* XC = (LAS float*)lds + w * (64 * XCS);
    const float* CINB = (const float*)(a.ws + WS_HT);
    LAS float* HL = (LAS float*)(lds + 8 * 64 * XCS * 4 + 2048) + w * 192;
    {
        const int rsub = lane >> 3, c8 = lane & 7;
        const bf16_t* px = PROJ + (size_t)tok0 * NIN + 1536 + 64 * w + 8 * c8;
        u32x4 rv[9];
#pragma unroll
        for (int i = 0; i < 9; ++i) { const int row = 8 * i - 8 + rsub; rv[i] = (u32x4){0u, 0u, 0u, 0u};
            if (row >= 0 || (c > 0 && row >= -3)) rv[i] = *(const u32x4*)(px + (long)row * NIN); }
#pragma unroll
        for (int i = 0; i < 9; ++i) { const int row = 8 * i - 8 + rsub;
            const f32x4 lo = (f32x4){bf_lo(rv[i].x), bf_hi(rv[i].x), bf_lo(rv[i].y), bf_hi(rv[i].y)}, hi = (f32x4){bf_lo(rv[i].z), bf_hi(rv[i].z), bf_lo(rv[i].w), bf_hi(rv[i].w)};
            if (row >= 0) { *(LAS f32x4*)(XC + row * XCS + 8 * c8) = lo; *(LAS f32x4*)(XC + row * XCS + 8 * c8 + 4) = hi; }
            else if (row >= -3) { *(LAS f32x4*)(HL + (row + 3) * 64 + 8 * c8) = lo; *(LAS f32x4*)(HL + (row + 3) * 64 + 8 * c8 + 4) = hi; } }
    }
    asm volatile("s_waitcnt lgkmcnt(0)" ::: "memory");
    {
        const int cgl = 64 * w + lane;
        const float w0 = a.rcw[cgl], w1 = a.rcw[512 + cgl], w2 = a.rcw[1024 + cgl], w3 = a.rcw[1536 + cgl], cb = a.rcb[cgl];
        float x3 = HL[lane], x2 = HL[64 + lane], x1 = HL[128 + lane];
#pragma unroll 8
        for (int tt = 0; tt < 64; ++tt) {
            const float x0 = XC[tt * XCS + lane];
            XC[tt * XCS + lane] = cb + w0 * x3 + w1 * x2 + w2 * x1 + w3 * x0;
            x3 = x2; x2 = x1; x1 = x0;
        }
    }
    __syncthreads();
    bf16x8 af[4][2];
#pragma unroll
    for (int mt = 0; mt < 4; ++mt)
#pragma unroll
        for (int kk = 0; kk < 2; ++kk) {
            const LAS float* p = XC + (16 * mt + fr) * XCS + 32 * kk + 8 * fq;
            const f32x4 v0 = *(const LAS f32x4*)p, v1 = *(const LAS f32x4*)(p + 4);
            u32x4 pk; pk.x = pk2(v0[0], v0[1]); pk.y = pk2(v0[2], v0[3]); pk.z = pk2(v1[0], v1[1]); pk.w = pk2(v1[2], v1[3]);
            af[mt][kk] = __builtin_bit_cast(bf16x8, pk);
        }
    const bf16_t* WGT = (const bf16_t*)(a.ws + WS_WG);
    bf16x8 nbr[2], nbi[2]; float nbrg, nbig, nlam, ncin = 0.f;
    { const int chl = fr, cgl = 64 * w + chl;
#pragma unroll
        for (int kk = 0; kk < 2; ++kk) { nbr[kk] = *(const bf16x8*)(WGT + ((size_t)(w * 64 + chl) * 64 + 32 * kk + 8 * fq)); nbi[kk] = *(const bf16x8*)(WGT + 32768 + ((size_t)(w * 64 + chl) * 64 + 32 * kk + 8 * fq)); }
        nbrg = a.b_rg[cgl]; nbig = a.b_ig[cgl]; nlam = a.lam[cgl]; if (FINAL) ncin = CINB[(size_t)item * 512 + cgl]; }
#pragma unroll 1
    for (int nt = 0; nt < 4; ++nt) {
        const int chl = 16 * nt + fr, cgl = 64 * w + chl;
        const bf16x8 br0 = nbr[0], br1 = nbr[1], bi0 = nbi[0], bi1 = nbi[1];
        const float brgl = -LOG2E * nbrg, bigl = -LOG2E * nbig, cin0 = ncin;
        const float sp8 = -8.0f * log1pf(expf(-nlam));
        const float sp8l = sp8 * LOG2E, sp82 = 2.f * sp8;
        if (nt < 3) { const int chn = chl + 16, cgn = cgl + 16;
#pragma unroll
            for (int kk = 0; kk < 2; ++kk) { nbr[kk] = *(const bf16x8*)(WGT + ((size_t)(w * 64 + chn) * 64 + 32 * kk + 8 * fq)); nbi[kk] = *(const bf16x8*)(WGT + 32768 + ((size_t)(w * 64 + chn) * 64 + 32 * kk + 8 * fq)); }
            nbrg = a.b_rg[cgn]; nbig = a.b_ig[cgn]; nlam = a.lam[cgn]; if (FINAL) ncin = CINB[(size_t)item * 512 + cgn]; }
        float carry = 0.f, cumP = 1.f;
        if (FINAL) carry = cin0;
#pragma unroll
        for (int mt = 0; mt < 4; ++mt) {
            f32x4 dr = (f32x4){0.f, 0.f, 0.f, 0.f}, di = dr;
            dr = __builtin_amdgcn_mfma_f32_16x16x32_bf16(af[mt][0], br0, dr, 0, 0, 0); dr = __builtin_amdgcn_mfma_f32_16x16x32_bf16(af[mt][1], br1, dr, 0, 0, 0);
            di = __builtin_amdgcn_mfma_f32_16x16x32_bf16(af[mt][0], bi0, di, 0, 0, 0); di = __builtin_amdgcn_mfma_f32_16x16x32_bf16(af[mt][1], bi1, di, 0, 0, 0);
            float hl[4], pl[4];
#pragma unroll
            for (int j = 0; j < 4; ++j) {
                const float r = fast_rcp(1.f + fast_exp2(fmaf(dr[j], -LOG2E, brgl))), ig = fast_rcp(1.f + fast_exp2(fmaf(di[j], -LOG2E, bigl)));
                const float av = fast_exp2(sp8l * r), x2 = sp82 * r;
                const float ser = -x2 * (1.f + x2 * (0.5f + x2 * (0.16666667f + x2 * (0.041666668f + x2 * 0.0083333338f))));
                const float om = (x2 > -0.3f) ? ser : (1.f - av * av);
                const float mult = __builtin_amdgcn_sqrtf(om);
                const float xv = XC[(16 * mt + 4 * fq + j) * XCS + chl];
                const float uv = mult * ig * xv;
                if (j == 0) { hl[0] = uv; pl[0] = av; } else { hl[j] = av * hl[j - 1] + uv; pl[j] = av * pl[j - 1]; }
            }
            float IA = pl[3], IH = hl[3];
            { const float pa = __shfl_up(IA, 16), ph = __shfl_up(IH, 16); if (fq >= 1) { IH = IA * ph + IH; IA = IA * pa; } }
            { const float pa = __shfl_up(IA, 32), ph = __shfl_up(IH, 32); if (fq >= 2) { IH = IA * ph + IH; IA = IA * pa; } }
            float EA = __shfl_up(IA, 16), EH = __shfl_up(IH, 16); if (fq == 0) { EA = 1.f; EH = 0.f; }
            const float hs = EA * carry + EH, ps = EA * cumP;
            if (FINAL) {
#pragma unroll
                for (int j = 0; j < 4; ++j) XC[(16 * mt + 4 * fq + j) * XCS + chl] = pl[j] * hs + hl[j];
            }
            const float TA = __shfl(IA, 48 + fr), TH = __shfl(IH, 48 + fr);
            carry = TA * carry + TH; cumP = TA * cumP;
            (void)ps;
        }
        if (!FINAL && fq == 0) { CHA[(size_t)item * 512 + cgl] = cumP; CHH[(size_t)item * 512 + cgl] = carry; }
    }
}

constexpr int QS_B = 144, VT_B = 784;
constexpr int AQ_OFF = 0, AK_OFF = 256 * QS_B, AV_OFF = AK_OFF + 384 * QS_B;
static_assert(AV_OFF + 64 * VT_B <= MISC_OFF, "attention LDS map");
struct AttnItem { int g, b, h, c, n0; };
__device__ __forceinline__ AttnItem attn_item(int k, int G, int bid) {
    int bh, idx;
    if (G == 256) { const int x = bid & 7, j = bid >> 3, p = 32 * (k % 6) + j; bh = 4 * x + p / 48; idx = p % 48; }
    else { const int p = (bid + k * G) % 1536; bh = p / 48; idx = p % 48; }
    AttnItem it; it.g = idx >> 4; it.b = bh >> 3; it.h = bh & 7; const int cn = 2 * (idx & 15), nbk = 32 >> (2 * it.g); it.c = cn / nbk; it.n0 = cn % nbk; return it;
}
__device__ __forceinline__ void attn_load(const bf16_t* PROJ, const AttnItem it, int tid, u32x4 (&pq)[4], u32x4 (&pk)[6], u32x4 (&pv0)[3], u32x4 (&pv1)[3]) {
    const int ds = 2 * it.g, n0 = it.n0;
    const int qb = (it.b * SEQ + (128 * n0) * (1 << ds) + it.c) * NIN + it.h * 64;
    const int kb_ = (it.b * SEQ + (128 * (n0 - 1)) * (1 << ds) + it.c) * NIN + it.h * 64;
    const int rstep = NIN << ds;
#pragma unroll
    for (int i = 0; i < 4; ++i) { const int task = tid + 512 * i, row = task >> 3, ch = task & 7;
        pq[i] = *(const u32x4*)(PROJ + (qb + row * rstep + 8 * ch)); }
#pragma unroll
    for (int i = 0; i < 6; ++i) { const int task = tid + 512 * i, row = task >> 3, ch = task & 7;
        pk[i] = (u32x4){0u, 0u, 0u, 0u};
        if (n0 > 0 || row >= 128) pk[i] = *(const u32x4*)(PROJ + (kb_ + row * rstep + 512 + 8 * ch)); }
#pragma unroll
    for (int i = 0; i < 3; ++i) { const int kp = 8 * (3 * (tid >> 6) + i) + ((tid & 63) >> 3), dc = tid & 7, key = 2 * kp;
        pv0[i] = (u32x4){0u, 0u, 0u, 0u}; pv1[i] = pv0[i];
        if (n0 > 0 || key >= 128) { const int eo = kb_ + key * rstep + 1024 + 8 * dc; pv0[i] = *(const u32x4*)(PROJ + eo); pv1[i] = *(const u32x4*)(PROJ + (eo + rstep)); } }
}
__device__ __forceinline__ void attn_stage(LAS unsigned char* lds, int tid, const u32x4 (&pq)[4], const u32x4 (&pk)[6], const u32x4 (&pv0)[3], const u32x4 (&pv1)[3]) {
#pragma unroll
    for (int i = 0; i < 4; ++i) { const int task = tid + 512 * i, row = task >> 3, ch = task & 7; *(LAS u32x4*)(lds + AQ_OFF + row * QS_B + ch * 16) = pq[i]; }
#pragma unroll
    for (int i = 0; i < 6; ++i) { const int task = tid + 512 * i, row = task >> 3, ch = task & 7; *(LAS u32x4*)(lds + AK_OFF + row * QS_B + ch * 16) = pk[i]; }
#pragma unroll
    for (int i = 0; i < 3; ++i) { const int kp = 8 * (3 * (tid >> 6) + i) + ((tid & 63) >> 3), dc = tid & 7, key = 2 * kp;
        const u32x4 v0 = pv0[i], v1 = pv1[i];
        const int rr = key & 31, phys0 = (key & ~31) + 8 * ((rr & 15) >> 2) + 4 * (rr >> 4) + (rr & 3);
        const int phys = (((phys0 >> 3) ^ dc) << 3) | (phys0 & 7);
        LAS unsigned char* vb = lds + AV_OFF + (8 * dc) * VT_B + phys * 2;
        *(LAS unsigned*)(vb + 0 * VT_B) = (v0.x & 0xffffu) | (v1.x << 16); *(LAS unsigned*)(vb + 1 * VT_B) = (v0.x >> 16) | (v1.x & 0xffff0000u);
        *(LAS unsigned*)(vb + 2 * VT_B) = (v0.y & 0xffffu) | (v1.y << 16); *(LAS unsigned*)(vb + 3 * VT_B) = (v0.y >> 16) | (v1.y & 0xffff0000u);
        *(LAS unsigned*)(vb + 4 * VT_B) = (v0.z & 0xffffu) | (v1.z << 16); *(LAS unsigned*)(vb + 5 * VT_B) = (v0.z >> 16) | (v1.z & 0xffff0000u);
        *(LAS unsigned*)(vb + 6 * VT_B) = (v0.w & 0xffffu) | (v1.w << 16); *(LAS unsigned*)(vb + 7 * VT_B) = (v0.w >> 16) | (v1.w & 0xffff0000u); }
}
__device__ __forceinline__ void attn_phase(const Args& a, LAS unsigned char* lds, int G, int bid, int tid) {
    const int lane = tid & 63, w = __builtin_amdgcn_readfirstlane(tid >> 6), fr = lane & 15, fq = lane >> 4;
    const bf16_t* PROJ = (const bf16_t*)(a.ws + WS_PROJ);
    bf16_t* OB = (bf16_t*)(a.ws + WS_OB); float* LS = (float*)(a.ws + WS_LSUM);
    const float M2 = 8.0f * LOG2E * wave_max(fabsf(a.qg[lane])) * wave_max(fabsf(a.kg[lane]));
    const int nk = ((G == 256) ? 6 : (1536 - bid + G - 1) / G) * REPI_P2;
    u32x4 pq[4], pk[6], pv0[3], pv1[3];
    AttnItem cur = attn_item(0, G, bid);
    if (nk > 0) attn_load(PROJ, cur, tid, pq, pk, pv0, pv1);
    for (int k = 0; k < nk; ++k) {
        const int g = cur.g, h = cur.h, c = cur.c, n0 = cur.n0, ds = 2 * g;
        const size_t tokb = (size_t)cur.b * SEQ;
        __syncthreads();
        attn_stage(lds, tid, pq, pk, pv0, pv1);
        __syncthreads();
        if (k + 1 < nk) { cur = attn_item(k + 1, G, bid); attn_load(PROJ, cur, tid, pq, pk, pv0, pv1); }
        const int tb = w >> 2, q0 = 32 * (w & 3);
        bf16x8 qf[2][2];
#pragma unroll
        for (int qt = 0; qt < 2; ++qt)
#pragma unroll
            for (int kk = 0; kk < 2; ++kk) qf[qt][kk] = *(const LAS bf16x8*)(lds + AQ_OFF + (128 * tb + q0 + 16 * qt + fr) * QS_B + (32 * kk + 8 * fq) * 2);
        f32x4 o[2][4];
#pragma unroll
        for (int qt = 0; qt < 2; ++qt)
#pragma unroll
            for (int dt = 0; dt < 4; ++dt) o[qt][dt] = (f32x4){0.f, 0.f, 0.f, 0.f};
        float lsum[2] = {0.f, 0.f};
        const bool pad = (tb == 0 && n0 == 0);
#pragma unroll 1
        for (int blk = 0; blk < 5; ++blk) {
            const int kb = q0 + 32 * blk;
            if (pad && kb + 32 <= 128) continue;
            const int kw = 128 * tb + kb;
            bf16x8 kf[2][2], vf[4];
#pragma unroll
            for (int t = 0; t < 2; ++t)
#pragma unroll
                for (int kk = 0; kk < 2; ++kk) kf[t][kk] = *(const LAS bf16x8*)(lds + AK_OFF + (kw + 16 * t + fr) * QS_B + (32 * kk + 8 * fq) * 2);
#pragma unroll
            for (int dt = 0; dt < 4; ++dt) vf[dt] = *(const LAS bf16x8*)(lds + AV_OFF + (16 * dt + fr) * VT_B + ((((kw >> 3) + fq) ^ ((2 * dt + (fr >> 3)) & 7)) << 4));
            f32x4 s[2][2];
#pragma unroll
            for (int qt = 0; qt < 2; ++qt)
#pragma unroll
                for (int t = 0; t < 2; ++t) { s[qt][t] = (f32x4){-M2, -M2, -M2, -M2};
#pragma unroll
                    for (int kk = 0; kk < 2; ++kk) s[qt][t] = __builtin_amdgcn_mfma_f32_16x16x32_bf16(kf[t][kk], qf[qt][kk], s[qt][t], 0, 0, 0); }
            float p[2][2][4];
            if (blk >= 1 && blk <= 3) {
#pragma unroll
                for (int qt = 0; qt < 2; ++qt)
#pragma unroll
                    for (int t = 0; t < 2; ++t)
#pragma unroll
                        for (int j = 0; j < 4; ++j) { const float pv = fast_exp2(s[qt][t][j]); p[qt][t][j] = pv; lsum[qt] += pv; }
            } else {
#pragma unroll
                for (int qt = 0; qt < 2; ++qt) {
                    const int qi = q0 + 16 * qt + fr;
                    const int dlo = pad ? max(0, 128 - qi) : 0;
                    const int dbase = kb + 4 * fq - qi - dlo;
#pragma unroll
                    for (int t = 0; t < 2; ++t)
#pragma unroll
                        for (int j = 0; j < 4; ++j) { const bool valid = (unsigned)(dbase + 16 * t + j) <= (unsigned)(128 - dlo);
                            const float pv = valid ? fast_exp2(s[qt][t][j]) : 0.f; p[qt][t][j] = pv; lsum[qt] += pv; }
                }
            }
#pragma unroll
            for (int qt = 0; qt < 2; ++qt) {
                u32x4 pkd; pkd.x = pk2(p[qt][0][0], p[qt][0][1]); pkd.y = pk2(p[qt][0][2], p[qt][0][3]); pkd.z = pk2(p[qt][1][0], p[qt][1][1]); pkd.w = pk2(p[qt][1][2], p[qt][1][3]);
                const bf16x8 pb = __builtin_bit_cast(bf16x8, pkd);
#pragma unroll
                for (int dt = 0; dt < 4; ++dt) o[qt][dt] = __builtin_amdgcn_mfma_f32_16x16x32_bf16(vf[dt], pb, o[qt][dt], 0, 0, 0);
            }
        }
#pragma unroll
        for (int qt = 0; qt < 2; ++qt) {
            float ls = lsum[qt]; ls += __shfl_xor(ls, 16); ls += __shfl_xor(ls, 32);
            const float inv = 1.0f / ls;
            const size_t tq = tokb + (((size_t)(128 * (n0 + tb) + q0 + 16 * qt + fr)) << ds) + c;
            bf16_t* op = OB + ((size_t)g * MTOK + tq) * 512 + h * 64 + 4 * fq;
#pragma unroll
            for (int dt = 0; dt < 4; ++dt) { u32x2 wv; wv.x = pk2(o[qt][dt][0] * inv, o[qt][dt][1] * inv); wv.y = pk2(o[qt][dt][2] * inv, o[qt][dt][3] * inv); *(u32x2*)(op + 16 * dt) = wv; }
            if (fq == 0) LS[((size_t)g * MTOK + tq) * 8 + h] = ls;
        }
    }
}

__global__ void __launch_bounds__(512, 2) fwd_kernel(Args a) {
    extern __shared__ __attribute__((aligned(16))) unsigned char lds_raw[];
    LAS unsigned char* lds = (LAS unsigned char*)lds_raw;
    cg::grid_group grid = cg::this_grid();
    const int wave = __builtin_amdgcn_readfirstlane(threadIdx.x >> 6);
    const int G = gridDim.x, bid = blockIdx.x;
#define FRESH_TID() const int lane = fresh_lane(), tid = wave * 64 + lane; (void)tid; (void)lane
    const int gw = bid * 8 + wave, NGW = G * 8;
    unsigned char* ws = a.ws;
    bf16_t* WIN = (bf16_t*)(ws + WS_WIN); bf16_t* WOUT = (bf16_t*)(ws + WS_WOUT); bf16_t* WDN = (bf16_t*)(ws + WS_WDN); bf16_t* WUP = (bf16_t*)(ws + WS_WUP);
    bf16_t* XN = (bf16_t*)(ws + WS_XN); bf16_t* PROJ = (bf16_t*)(ws + WS_PROJ); bf16_t* MIX = (bf16_t*)(ws + WS_MIX); bf16_t* ACT = (bf16_t*)(ws + WS_ACT);
    bf16_t* OB = (bf16_t*)(ws + WS_OB); float* LS = (float*)(ws + WS_LSUM);
    unsigned* BARW = (unsigned*)(ws + WS_BAR); bf16_t* WGT = (bf16_t*)(ws + WS_WG);
    if (threadIdx.x < 2) ((volatile LAS unsigned*)(lds + MISC_OFF))[threadIdx.x] = 0u;
    __syncthreads();
    (void)xcd_barrier_post(BARW, (volatile LAS unsigned*)(lds + MISC_OFF));
#define GSYNC() do { XcdBarrier xb_; xb_.bar = (unsigned*)(a.ws + WS_BAR); xb_.x = xb_xcc_id(); xb_.st = (volatile LAS unsigned*)(lds + MISC_OFF); xcd_barrier(xb_); } while (0)
    float* RS = (float*)(ws + WS_RS); float* RS0 = (float*)(ws + WS_RS0); f32x2* CS = (f32x2*)(ws + WS_CS); float* HT = (float*)(ws + WS_HT); float* HB = (float*)(ws + WS_HB);

    for (int rep = 0; rep < REP_P0; ++rep) {
        if (rep) GSYNC();
        FRESH_TID();
        LAS float* scr = (LAS float*)(lds + wave * 16384);
        constexpr int I_IN = (DM / 64) * (NIN / 32);
        for (int it = gw; it < I_IN; it += NGW) transpose_item(a.w_in, DM, NIN, WIN, scr, it, lane, a.g_mix, false);
        {
            for (int m0 = gw * 4; m0 < MTOK; m0 += NGW * 4) {
                f32x4 v[4][4];
#pragma unroll
                for (int q = 0; q < 4; ++q) { const f32x4* xr = (const f32x4*)(a.x + (size_t)(m0 + q) * DM) + lane;
#pragma unroll
                    for (int j = 0; j < 4; ++j) v[q][j] = __builtin_nontemporal_load(xr + 64 * j); }
#pragma unroll
                for (int q = 0; q < 4; ++q) { float s = 0.f;
#pragma unroll
                    for (int j = 0; j < 4; ++j) s += (v[q][j][0] * v[q][j][0] + v[q][j][1] * v[q][j][1]) + (v[q][j][2] * v[q][j][2] + v[q][j][3] * v[q][j][3]);
                    const float ssum = wave_sum(s);
                    if (lane == 0) RS0[m0 + q] = ssum;
                    u32x2* o8 = (u32x2*)(XN + (size_t)(m0 + q) * DM) + lane;
#pragma unroll
                    for (int j = 0; j < 4; ++j) { u32x2 wv; wv.x = pk2(v[q][j][0], v[q][j][1]); wv.y = pk2(v[q][j][2], v[q][j][3]); o8[64 * j] = wv; } }
            }
        }
        for (int idx = bid * 512 + tid; idx < MTOK * 32; idx += G * 512) {
            const int tok = idx >> 5, i = idx & 31;
            const float invf = powf(10000.0f, -(float)i * (1.0f / 32.0f));
            const float ang = (float)a.pos[tok] * invf;
            const float kq = rintf(ang * 0.15915494309189535f);
            float rr = fmaf(-kq, 6.2831854820251465f, ang); rr = fmaf(-kq, -1.7484556000744883e-07f, rr);
            CS[idx] = (f32x2){__cosf(rr), __sinf(rr)};
        }
        for (int idx = bid * 512 + tid; idx < 2 * 8 * 64 * 64; idx += G * 512) {
            const int in = idx & 63, out = (idx >> 6) & 63, n = (idx >> 12) & 7, mat = idx >> 15;
            WGT[idx] = (bf16_t)f2bf((mat ? a.w_ig : a.w_rg)[(n * 64 + in) * 64 + out]);
        }
    }
    if (a.ws == nullptr) grid.sync();
    GSYNC();
#define GSYNC_UNUSED() do { XcdBarrier xb_; xb_.bar = (unsigned*)(a.ws + WS_BAR); xb_.x = xb_xcc_id(); xb_.st = (volatile LAS unsigned*)(lds + MISC_OFF); xcd_barrier(xb_); } while (0)
    for (int rep = 0; rep < REP_SYNC; ++rep) GSYNC();

    for (int rep = 0; rep < REP_P1; ++rep) {
        if (rep) GSYNC();
        pg8::Gemm g{XN, WIN, MTOK, NIN, DM}; pg8::StaticOrder S; S.init(MTOK, NIN, G, bid, REPG_P1);
        pg8::EpiStoreBf16 E{PROJ, NIN, RS0};
        pg8::gemm_phase<pg8::EpiStoreBf16, pg8::StaticOrder, true, true>(lds, g, S, E, wave);
        if (rep == 0) {
            FRESH_TID();
            constexpr int NU = (MTOK / 256) * (NIN / 256) * REPG_P1;
            const int rem = NU % G, first = rem, nwg = G - first;
            if (bid >= first) {
                LAS float* scr = (LAS float*)(lds + wave * 16384);
                constexpr int I_OUT = (DM / 64) * (DM / 32), I_UP = (DM / 64) * (NUP / 32), I_DN = (DFF / 64) * (DM / 32);
                for (int it = (bid - first) * 8 + wave; it < I_OUT + I_UP + I_DN; it += nwg * 8) {
                    int r = it;
                    if (r < I_OUT) { transpose_item(a.w_out, DM, DM, WOUT, scr, r, lane, nullptr, false); continue; } r -= I_OUT;
                    if (r < I_UP) { transpose_item(a.w_up, DM, NUP, WUP, scr, r, lane, a.g_ffn, true); continue; } r -= I_UP;
                    transpose_item(a.w_down, DFF, DM, WDN, scr, r, lane, nullptr, false);
                }
            }
        }
    }
    GSYNC();

    {
        FRESH_TID();
        for (int rep = 0; rep < REP_LRUA; ++rep) { if (rep) GSYNC();
        for (int item = bid; item < 256; item += G) { __syncthreads(); lru_chunk<false>(a, lds, item, tid); } }
        {
            const int d0 = 8 * (lane & 7);
            const bool hi = (lane & 4) != 0;
            float gq[8], gk[8];
#pragma unroll
            for (int j = 0; j < 8; ++j) { gq[j] = a.qg[d0 + j] * (0.125f * LOG2E); gk[j] = a.kg[d0 + j]; }
            for (int tok0 = gw * 4; tok0 < MTOK; tok0 += NGW * 4) {
                u32x4 rq[4], rk[4]; f32x4 csv[4][4];
#pragma unroll
                for (int q = 0; q < 4; ++q) { const bf16_t* pq = PROJ + (size_t)(tok0 + q) * NIN + 8 * lane; rq[q] = *(const u32x4*)pq; rk[q] = *(const u32x4*)(pq + 512);
                    const f32x4* cs4 = (const f32x4*)(CS + (size_t)(tok0 + q) * 32 + 8 * (lane & 3));
#pragma unroll
                    for (int j = 0; j < 4; ++j) csv[q][j] = cs4[j]; }
#pragma unroll
                for (int q = 0; q < 4; ++q) {
                    float qv[8], kv[8];
                    qv[0] = bf_lo(rq[q].x); qv[1] = bf_hi(rq[q].x); qv[2] = bf_lo(rq[q].y); qv[3] = bf_hi(rq[q].y); qv[4] = bf_lo(rq[q].z); qv[5] = bf_hi(rq[q].z); qv[6] = bf_lo(rq[q].w); qv[7] = bf_hi(rq[q].w);
                    kv[0] = bf_lo(rk[q].x); kv[1] = bf_hi(rk[q].x); kv[2] = bf_lo(rk[q].y); kv[3] = bf_hi(rk[q].y); kv[4] = bf_lo(rk[q].z); kv[5] = bf_hi(rk[q].z); kv[6] = bf_lo(rk[q].w); kv[7] = bf_hi(rk[q].w);
                    float sq = 0.f, sk = 0.f;
#pragma unroll
                    for (int j = 0; j < 8; ++j) { sq += qv[j] * qv[j]; sk += kv[j] * kv[j]; }
                    sq += __shfl_xor(sq, 1); sq += __shfl_xor(sq, 2); sq += __shfl_xor(sq, 4);
                    sk += __shfl_xor(sk, 1); sk += __shfl_xor(sk, 2); sk += __shfl_xor(sk, 4);
                    const float rq_ = rsqrtf(sq * (1.f / 64.f) + EPS), rk_ = rsqrtf(sk * (1.f / 64.f) + EPS);
                    float oq[8], ok[8];
#pragma unroll
                    for (int j = 0; j < 8; ++j) {
                        const float qn = qv[j] * rq_ * gq[j], kn = kv[j] * rk_ * gk[j];
                        const float qp = __shfl_xor(qn, 4), kp = __shfl_xor(kn, 4);
                        const float cc = csv[q][j >> 1][2 * (j & 1)], sn = csv[q][j >> 1][2 * (j & 1) + 1];
                        oq[j] = hi ? (qn * cc + qp * sn) : (qn * cc - qp * sn);
                        ok[j] = hi ? (kn * cc + kp * sn) : (kn * cc - kp * sn);
                    }
                    u32x4 wq, wk; wq.x = pk2(oq[0], oq[1]); wq.y = pk2(oq[2], oq[3]); wq.z = pk2(oq[4], oq[5]); wq.w = pk2(oq[6], oq[7]);
                    wk.x = pk2(ok[0], ok[1]); wk.y = pk2(ok[2], ok[3]); wk.z = pk2(ok[4], ok[5]); wk.w = pk2(ok[6], ok[7]);
                    bf16_t* pq = PROJ + (size_t)(tok0 + q) * NIN + 8 * lane;
                    *(u32x4*)pq = wq; *(u32x4*)(pq + 512) = wk;
                }
            }
        }
    }
    GSYNC();

    {
        FRESH_TID();
        float* CINB = HT;
        const float* CHA = (const float*)(ws + WS_CHS); const float* CHH = CHA + 4 * 64 * 512;
        for (int p = gw; p < 4 * 512; p += NGW) {
            const int b = p >> 9, ch = p & 511; const size_t o = ((size_t)(b * 64 + lane)) * 512 + ch;
            float IA = CHA[o], IH = CHH[o];
#pragma unroll
            for (int off = 1; off < 64; off <<= 1) { const float pa = __shfl_up(IA, off), ph = __shfl_up(IH, off); if (lane >= off) { IH = IA * ph + IH; IA = IA * pa; } }
            float EH = __shfl_up(IH, 1); if (lane == 0) EH = 0.f;
            CINB[o] = EH;
        }
    }
    for (int rep = 0; rep < REP_P2; ++rep) { FRESH_TID(); attn_phase(a, lds, G, bid, tid); GSYNC(); }

    for (int rep = 0; rep < REP_P3; ++rep) { if (rep) GSYNC();
    FRESH_TID();
    for (int item = bid; item < 256; item += G) {
        __syncthreads();
        lru_chunk<true>(a, lds, item, tid);
        __syncthreads();
        const int tok0 = (item >> 6) * SEQ + (item & 63) * 64;
        const int nb = lane >> 3, c8 = 8 * (lane & 7);
        const f32x4 gr0 = *(const f32x4*)(a.g_rec + 8 * lane), gr1 = *(const f32x4*)(a.g_rec + 8 * lane + 4);
        const f32x4 ga0 = *(const f32x4*)(a.g_att + 8 * lane), ga1 = *(const f32x4*)(a.g_att + 8 * lane + 4);
        {
            u32x4 gwv[8];
#pragma unroll
            for (int ti = 0; ti < 8; ++ti) gwv[ti] = *(const u32x4*)(PROJ + ((size_t)tok0 + 8 * wave + ti) * NIN + 2048 + 8 * lane);
#pragma unroll
            for (int ti = 0; ti < 8; ++ti) {
                const int tt = 8 * wave + ti; const size_t tok = (size_t)tok0 + tt;
                const LAS float* hp = (const LAS float*)lds + nb * (64 * XCS) + tt * XCS + c8;
                const f32x4 h0 = *(const LAS f32x4*)hp, h1 = *(const LAS f32x4*)(hp + 4);
                const u32x4 gw_ = gwv[ti];
                float rv[8];
                rv[0] = h0[0] * gelu_tanh(bf_lo(gw_.x)); rv[1] = h0[1] * gelu_tanh(bf_hi(gw_.x)); rv[2] = h0[2] * gelu_tanh(bf_lo(gw_.y)); rv[3] = h0[3] * gelu_tanh(bf_hi(gw_.y));
                rv[4] = h1[0] * gelu_tanh(bf_lo(gw_.z)); rv[5] = h1[1] * gelu_tanh(bf_hi(gw_.z)); rv[6] = h1[2] * gelu_tanh(bf_lo(gw_.w)); rv[7] = h1[3] * gelu_tanh(bf_hi(gw_.w));
                float ss = 0.f;
#pragma unroll
                for (int j = 0; j < 8; ++j) ss += rv[j] * rv[j];
                const float rn = rsqrtf(wave_sum(ss) * (1.f / 512.f) + EPS);
                u32x4 wr_; wr_.x = pk2(rv[0] * rn * gr0[0], rv[1] * rn * gr0[1]); wr_.y = pk2(rv[2] * rn * gr0[2], rv[3] * rn * gr0[3]);
                wr_.z = pk2(rv[4] * rn * gr1[0], rv[5] * rn * gr1[1]); wr_.w = pk2(rv[6] * rn * gr1[2], rv[7] * rn * gr1[3]);
                *(u32x4*)(MIX + tok * DM + 512 + 8 * lane) = wr_;
            }
#pragma unroll
            for (int th = 0; th < 2; ++th) {
                u32x4 ov[4][3]; float lg[4][3];
#pragma unroll
                for (int q = 0; q < 4; ++q) { const size_t tok = (size_t)tok0 + 8 * wave + 4 * th + q;
#pragma unroll
                    for (int g = 0; g < 3; ++g) { lg[q][g] = LS[((size_t)g * MTOK + tok) * 8 + nb]; ov[q][g] = *(const u32x4*)(OB + ((size_t)g * MTOK + tok) * 512 + 8 * lane); } }
#pragma unroll
                for (int q = 0; q < 4; ++q) { const size_t tok = (size_t)tok0 + 8 * wave + 4 * th + q;
                    float av[8]; float lt = 0.f;
#pragma unroll
                    for (int j = 0; j < 8; ++j) av[j] = 0.f;
#pragma unroll
                    for (int g = 0; g < 3; ++g) { const float l_ = lg[q][g]; const u32x4 o_ = ov[q][g]; lt += l_;
                        av[0] += l_ * bf_lo(o_.x); av[1] += l_ * bf_hi(o_.x); av[2] += l_ * bf_lo(o_.y); av[3] += l_ * bf_hi(o_.y);
                        av[4] += l_ * bf_lo(o_.z); av[5] += l_ * bf_hi(o_.z); av[6] += l_ * bf_lo(o_.w); av[7] += l_ * bf_hi(o_.w); }
                    const float il = 1.0f / lt; float sa = 0.f;
#pragma unroll
                    for (int j = 0; j < 8; ++j) { av[j] *= il; sa += av[j] * av[j]; }
                    const float an = rsqrtf(wave_sum(sa) * (1.f / 512.f) + EPS);
                    u32x4 wa; wa.x = pk2(av[0] * an * ga0[0], av[1] * an * ga0[1]); wa.y = pk2(av[2] * an * ga0[2], av[3] * an * ga0[3]);
                    wa.z = pk2(av[4] * an * ga1[0], av[5] * an * ga1[1]); wa.w = pk2(av[6] * an * ga1[2], av[7] * an * ga1[3]);
                    *(u32x4*)(MIX + tok * DM + 8 * lane) = wa;
                }
            }
        }
    } }
    GSYNC();

    {
        pg8::Gemm g{MIX, WOUT, MTOK, DM, DM}; pg8::StaticOrder S; S.init(MTOK, DM, G, bid);
        pg8::EpiResid E{XN, XN, RS};
        pg8::gemm_phase<pg8::EpiResid, pg8::StaticOrder, true, true>(lds, g, S, E, wave);
    }
    GSYNC();

    for (int rep = 0; rep < REP_P5; ++rep) {
        if (rep) GSYNC();
        pg8::Gemm g{XN, WUP, MTOK, NUP, DM}; pg8::StaticOrder S; S.init(MTOK, NUP, G, bid, REPG_P5);
        pg8::EpiConvAct E{RS, a.fcw, a.fcb, ACT, HT, HB, lds + XLDS_OFF};
        pg8::gemm_phase<pg8::EpiConvAct, pg8::StaticOrder, true, true>(lds, g, S, E, wave);
    }
    GSYNC();

    {
        FRESH_TID();
        pg8::StaticOrder S0; S0.init(MTOK, DM, G, bid); pg8::Unit u0;
        for (int ui = 0; S0.next(ui, u0); ++ui) {
            const int pm = u0.pm;
            for (int v = tid; v < DFF / 4; v += 512) {
                const int c = 4 * v;
                f32x4 cv[2][2];
#pragma unroll
                for (int bj = 0; bj < 2; ++bj) {
                    const f32x4 t0 = *(const f32x4*)(HT + ((size_t)(pm * 2 + 0) * 2 + bj) * DFF + c), t1 = *(const f32x4*)(HT + ((size_t)(pm * 2 + 1) * 2 + bj) * DFF + c);
                    f32x4 b0 = (f32x4){0.f, 0.f, 0.f, 0.f}, b1 = b0;
                    if ((pm & 15) != 0) { b0 = *(const f32x4*)(HB + ((size_t)((pm - 1) * 2 + 0) * 2 + bj) * DFF + c); b1 = *(const f32x4*)(HB + ((size_t)((pm - 1) * 2 + 1) * 2 + bj) * DFF + c); }
                    const int col = bj * DFF + c;
                    const f32x4 w0 = *(const f32x4*)(a.fcw + col), w1 = *(const f32x4*)(a.fcw + NUP + col), w2 = *(const f32x4*)(a.fcw + 2 * NUP + col), bb = *(const f32x4*)(a.fcb + col);
                    cv[bj][0] = bb + w0 * b0 + w1 * b1 + w2 * t0;
                    cv[bj][1] = bb + w0 * b1 + w1 * t0 + w2 * t1;
                }
#pragma unroll
                for (int rr = 0; rr < 2; ++rr) { u32x2 wv;
                    wv.x = pk2(gelu_tanh(cv[0][rr][0]) * cv[1][rr][0], gelu_tanh(cv[0][rr][1]) * cv[1][rr][1]);
                    wv.y = pk2(gelu_tanh(cv[0][rr][2]) * cv[1][rr][2], gelu_tanh(cv[0][rr][3]) * cv[1][rr][3]);
                    *(u32x2*)(ACT + (size_t)(pm * 256 + rr) * DFF + c) = wv; }
            }
        }
        asm volatile("s_waitcnt vmcnt(0)" ::: "memory");
        __syncthreads();
    }

    {
        pg8::Gemm g{ACT, WDN, MTOK, DM, DFF}; pg8::StaticOrder S; S.init(MTOK, DM, G, bid);
        pg8::EpiDown E{XN, a.out};
        pg8::gemm_phase<pg8::EpiDown, pg8::StaticOrder, true, true>(lds, g, S, E, wave);
    }
    (void)OB; (void)LS;
}

extern "C" void kernel_launch(void* const* d_in, const int* in_sizes, int n_in, void* d_out, int out_size, void* d_ws, size_t ws_size, hipStream_t stream) {
    static int grid_blocks = 0;
    if (grid_blocks == 0) {
        if (n_in != 21 || ws_size < WS_END) { fprintf(stderr, "kernel_launch: unexpected inputs (n_in %d, ws %zu)\n", n_in, ws_size); grid_blocks = -1; return; }
        int dev = 0, cus = 0, per_cu = 0;
        hipGetDevice(&dev);
        hipDeviceGetAttribute(&cus, hipDeviceAttributeMultiprocessorCount, dev);
        hipFuncSetAttribute((const void*)fwd_kernel, hipFuncAttributeMaxDynamicSharedMemorySize, LDS_BYTES);
        hipOccupancyMaxActiveBlocksPerMultiprocessor(&per_cu, (const void*)fwd_kernel, 512, LDS_BYTES);
        if (per_cu < 1) per_cu = 1;
        grid_blocks = cus * per_cu;
        if (grid_blocks > 256) grid_blocks = 256;
        (void)hipGetLastError();
    }
    if (grid_blocks < 0) return;
    Args a{};
    a.x = (const float*)d_in[0]; a.pos = (const int*)d_in[1]; a.g_mix = (const float*)d_in[2]; a.w_in = (const float*)d_in[3];
    a.qg = (const float*)d_in[4]; a.kg = (const float*)d_in[5]; a.rcw = (const float*)d_in[6]; a.rcb = (const float*)d_in[7];
    a.w_rg = (const float*)d_in[8]; a.b_rg = (const float*)d_in[9]; a.w_ig = (const float*)d_in[10]; a.b_ig = (const float*)d_in[11];
    a.lam = (const float*)d_in[12]; a.g_att = (const float*)d_in[13]; a.g_rec = (const float*)d_in[14]; a.w_out = (const float*)d_in[15];
    a.g_ffn = (const float*)d_in[16]; a.w_up = (const float*)d_in[17]; a.fcw = (const float*)d_in[18]; a.fcb = (const float*)d_in[19];
    a.w_down = (const float*)d_in[20];
    a.out = (float*)d_out; a.ws = (unsigned char*)d_ws;
    (void)hipMemsetAsync(d_ws, 0, WS_ZERO_BYTES, stream);
    void* args[] = {&a};
    hipError_t e = hipLaunchCooperativeKernel((const void*)fwd_kernel, dim3(grid_blocks), dim3(512), args, LDS_BYTES, stream);
    if (e != hipSuccess) fprintf(stderr, "cooperative launch failed: %s (grid %d)\n", hipGetErrorString(e), grid_blocks);
}
```
